# Optimizing an MI355X kernel written in HIP

```python
import jax, jax.numpy as jnp
from jax import lax
import numpy as np

D_MODEL = 1024
BATCH = 8
SEQ = 2048
DEPTH = 4
DEC_BATCH = 32
DEC_SEQ = 1
PAST_LEN = 8192
PAGE_SIZE = 128

N_HEADS_A = 8
HEAD_DIM = 64
A_WIDTH = N_HEADS_A * HEAD_DIM
DILATED_BRANCHES = ((128, 1), (512, 4), (2048, 16))
MAX_WINDOW = 2048
ROPE_THETA = 10000.0
Q_BLOCK = 128
B_WIDTH = D_MODEL // 2
N_GROUPS_B = 8
B_GROUP_DIM = B_WIDTH // N_GROUPS_B
CHUNK = 128
D_CONV = D_MODEL
CONV_WIDTH = 31
D_FF = 4 * D_MODEL
EPS = 1e-6
N_AB_LAYERS = (DEPTH + 1) // 2
N_C_LAYERS = DEPTH // 2
IN_AB_WIDTH = 3 * A_WIDTH + 2 * B_WIDTH

kernel_name = "hybrid_dilated_gmlp_conformer_step"


def rms_norm(x, g):
    xf = x.astype(jnp.float32)
    y = xf * lax.rsqrt(jnp.mean(xf * xf, axis=-1, keepdims=True) + EPS)
    return (y * g.astype(jnp.float32)).astype(x.dtype)


def layer_norm(x, g, b):
    xf = x.astype(jnp.float32)
    mu = jnp.mean(xf, axis=-1, keepdims=True)
    xc = xf - mu
    y = xc * lax.rsqrt(jnp.mean(xc * xc, axis=-1, keepdims=True) + EPS)
    return (y * g.astype(jnp.float32) + b.astype(jnp.float32)).astype(x.dtype)


def rope(x, pos):
    inv = ROPE_THETA ** (-jnp.arange(0, HEAD_DIM, 2, dtype=jnp.float32) / HEAD_DIM)
    ang = pos.astype(jnp.float32)[:, None] * inv[None, :]
    cos = jnp.cos(ang)[None, :, None, :]
    sin = jnp.sin(ang)[None, :, None, :]
    xf = x.astype(jnp.float32)
    x1, x2 = xf[..., :HEAD_DIM // 2], xf[..., HEAD_DIM // 2:]
    out = jnp.concatenate([x1 * cos - x2 * sin, x2 * cos + x1 * sin], axis=-1)
    return out.astype(x.dtype)


def masked_softmax(s, valid):
    s = jnp.where(valid, s, -jnp.inf)
    m = jnp.max(s, axis=-1, keepdims=True)
    p = jnp.exp(s - m)
    den = jnp.sum(p, axis=-1, keepdims=True)
    return p / den, (m + jnp.log(den))[..., 0]


def ab_project(h, w_in, q_g, k_g, vb_g, vb_b, pos):
    z = h @ w_in
    n, l, _ = z.shape
    q, k, v, u_b, v_b = jnp.split(z, [A_WIDTH, 2 * A_WIDTH, 3 * A_WIDTH, 3 * A_WIDTH + B_WIDTH], axis=-1)
    q = rope(rms_norm(q.reshape(n, l, N_HEADS_A, HEAD_DIM), q_g), pos)
    k = rope(rms_norm(k.reshape(n, l, N_HEADS_A, HEAD_DIM), k_g), pos)
    v = v.reshape(n, l, N_HEADS_A, HEAD_DIM)
    u_b = jax.nn.gelu(u_b)
    v_b = layer_norm(jax.nn.gelu(v_b), vb_g, vb_b)
    return q, k, v, u_b, v_b


def banded_attention(q, k, v, n_back):
    n, l, h, dh = q.shape
    nb = -(-l // Q_BLOCK)
    lp = nb * Q_BLOCK
    pad = ((0, 0), (0, lp - l), (0, 0), (0, 0))
    q, k, v = jnp.pad(q, pad), jnp.pad(k, pad), jnp.pad(v, pad)
    qb = q.reshape(n, nb, Q_BLOCK, h, dh)

    def two_blocks(t):
        cur = t.reshape(n, nb, Q_BLOCK, h, dh)
        prev = jnp.pad(t, ((0, 0), (Q_BLOCK, 0), (0, 0), (0, 0)))[:, :lp].reshape(n, nb, Q_BLOCK, h, dh)
        return jnp.concatenate([prev, cur], axis=2)

    kw, vw = two_blocks(k), two_blocks(v)
    s = jnp.einsum('nbqhd,nbkhd->nbhqk', qb, kw).astype(jnp.float32) * (dh ** -0.5)
    blk = jnp.arange(nb)[:, None, None] * Q_BLOCK
    qpos = blk + jnp.arange(Q_BLOCK)[None, :, None]
    kpos = blk - Q_BLOCK + jnp.arange(2 * Q_BLOCK)[None, None, :]
    dist = qpos - kpos
    valid = (dist >= 0) & (dist <= n_back) & (kpos >= 0)
    p, lse = masked_softmax(s, valid[None, :, None])
    o = jnp.einsum('nbhqk,nbkhd->nbqhd', p.astype(v.dtype), vw).reshape(n, lp, h, dh)[:, :l]
    lse = lse.transpose(0, 1, 3, 2).reshape(n, lp, h)[:, :l]
    return o, lse


def combine_branches(outs, lses):
    w = jax.nn.softmax(jnp.stack(lses, axis=0), axis=0)
    o = jnp.sum(w[..., None] * jnp.stack(outs, axis=0).astype(jnp.float32), axis=0)
    return o.astype(outs[0].dtype)


def dilated_attention_prompt(q, k, v):
    b, t, h, dh = q.shape
    outs, lses = [], []
    for window, dil in DILATED_BRANCHES:
        l = t // dil

        def to_sub(x):
            return x.reshape(b, l, dil, h, dh).transpose(0, 2, 1, 3, 4).reshape(b * dil, l, h, dh)

        o, lse = banded_attention(to_sub(q), to_sub(k), to_sub(v), window // dil)
        outs.append(o.reshape(b, dil, l, h, dh).transpose(0, 2, 1, 3, 4).reshape(b, t, h, dh))
        lses.append(lse.reshape(b, dil, l, h).transpose(0, 2, 1, 3).reshape(b, t, h))
    return combine_branches(outs, lses)


def dilated_attention_sample(q, k_all, v_all, q_pos, buf_start):
    outs, lses = [], []
    for window, dil in DILATED_BRANCHES:
        n_back = window // dil
        key_pos = q_pos[:, None] - dil * jnp.arange(n_back + 1)[None, :]
        valid = key_pos >= 0
        idx = jnp.clip(key_pos - buf_start, 0, k_all.shape[1] - 1)
        kg = jnp.take(k_all, idx, axis=1)
        vg = jnp.take(v_all, idx, axis=1)
        s = jnp.einsum('nshd,nskhd->nhsk', q, kg).astype(jnp.float32) * (HEAD_DIM ** -0.5)
        p, lse = masked_softmax(s, valid[None, None])
        outs.append(jnp.einsum('nhsk,nskhd->nshd', p.astype(vg.dtype), vg))
        lses.append(lse.transpose(0, 2, 1))
    return combine_branches(outs, lses)


def spatial_gate(u, v, w_s, b_s):
    n, l, _ = v.shape
    nc = -(-l // CHUNK)
    lp = nc * CHUNK
    vp = jnp.pad(v, ((0, 0), (0, lp - l), (0, 0))).reshape(n, nc, CHUNK, N_GROUPS_B, B_GROUP_DIM)
    mask = jnp.tril(jnp.ones((CHUNK, CHUNK), dtype=bool))
    w = jnp.where(mask[None], w_s, jnp.zeros_like(w_s))
    mixed = jnp.einsum('gij,ncjgd->ncigd', w, vp) + b_s.T[None, None, :, :, None]
    mixed = mixed.reshape(n, lp, B_WIDTH)[:, :l]
    return u * mixed


def conv_module(h, buf, w_in, w_dw, b_dw, g, b, w_out):
    z = h @ w_in
    a, gate = jnp.split(z, 2, axis=-1)
    x = a * jax.nn.sigmoid(gate)
    xc = jnp.concatenate([buf.astype(x.dtype), x], axis=1)
    y = lax.conv_general_dilated(xc, w_dw[:, None, :], window_strides=(1,), padding='VALID',
                                 dimension_numbers=('NWC', 'WIO', 'NWC'), feature_group_count=D_CONV) + b_dw
    y = jax.nn.silu(layer_norm(y, g, b))
    return y @ w_out, xc[:, -(CONV_WIDTH - 1):]


def ffn(h, w_up, w_down):
    return jnp.square(jax.nn.relu(h @ w_up)) @ w_down


def setup_inputs(seed: int = 0) -> dict:
    key = jax.random.key(seed)
    ks = jax.random.split(key, 24)
    win_buf = min(MAX_WINDOW, PAST_LEN)

    def nrm(k, shape, scale):
        return jax.random.normal(k, shape, jnp.float32) * scale

    def gain(k, shape):
        return 1.0 + 0.05 * jax.random.normal(k, shape, jnp.float32)

    return {
        "x_prompt": nrm(ks[0], (BATCH, SEQ, D_MODEL), 1.0),
        "x_sample": nrm(ks[1], (DEC_BATCH, DEC_SEQ, D_MODEL), 1.0),
        "cache_a_k": nrm(ks[2], (N_AB_LAYERS, DEC_BATCH, win_buf, N_HEADS_A, HEAD_DIM), 1.0),
        "cache_a_v": nrm(ks[3], (N_AB_LAYERS, DEC_BATCH, win_buf, N_HEADS_A, HEAD_DIM), 1.0),
        "state_c_conv": nrm(ks[4], (N_C_LAYERS, DEC_BATCH, CONV_WIDTH - 1, D_CONV), 0.5),
        "norm_mix_g": gain(ks[5], (DEPTH, D_MODEL)),
        "norm_ffn_g": gain(ks[6], (DEPTH, D_MODEL)),
        "w_ffn_up": nrm(ks[7], (DEPTH, D_MODEL, D_FF), D_MODEL ** -0.5),
        "w_ffn_down": nrm(ks[8], (DEPTH, D_FF, D_MODEL), D_FF ** -0.5),
        "w_in_ab": nrm(ks[9], (N_AB_LAYERS, D_MODEL, IN_AB_WIDTH), D_MODEL ** -0.5),
        "q_norm_g": gain(ks[10], (N_AB_LAYERS, HEAD_DIM)),
        "k_norm_g": gain(ks[11], (N_AB_LAYERS, HEAD_DIM)),
        "vb_norm_g": gain(ks[12], (N_AB_LAYERS, B_WIDTH)),
        "vb_norm_b": nrm(ks[13], (N_AB_LAYERS, B_WIDTH), 0.02),
        "w_spatial": nrm(ks[14], (N_AB_LAYERS, N_GROUPS_B, CHUNK, CHUNK), CHUNK ** -0.5),
        "b_spatial": gain(ks[15], (N_AB_LAYERS, N_GROUPS_B, CHUNK)),
        "w_out_ab": nrm(ks[16], (N_AB_LAYERS, A_WIDTH + B_WIDTH, D_MODEL), (A_WIDTH + B_WIDTH) ** -0.5),
        "w_c_in": nrm(ks[17], (N_C_LAYERS, D_MODEL, 2 * D_CONV), D_MODEL ** -0.5),
        "w_c_dw": nrm(ks[18], (N_C_LAYERS, CONV_WIDTH, D_CONV), CONV_WIDTH ** -0.5),
        "b_c_dw": nrm(ks[19], (N_C_LAYERS, D_CONV), 0.02),
        "c_norm_g": gain(ks[20], (N_C_LAYERS, D_CONV)),
        "c_norm_b": nrm(ks[21], (N_C_LAYERS, D_CONV), 0.02),
        "w_c_out": nrm(ks[22], (N_C_LAYERS, D_CONV, D_MODEL), D_CONV ** -0.5),
    }


def reference(x_prompt, x_sample, cache_a_k, cache_a_v, state_c_conv, norm_mix_g, norm_ffn_g, w_ffn_up, w_ffn_down,
              w_in_ab, q_norm_g, k_norm_g, vb_norm_g, vb_norm_b, w_spatial, b_spatial, w_out_ab,
              w_c_in, w_c_dw, b_c_dw, c_norm_g, c_norm_b, w_c_out):
    pos_p = jnp.arange(SEQ, dtype=jnp.int32)
    pos_s = PAST_LEN + jnp.arange(DEC_SEQ, dtype=jnp.int32)
    win_buf = cache_a_k.shape[2]
    buf_start = PAST_LEN - win_buf
    prompt_buf = min(MAX_WINDOW, SEQ)
    last_chunk_start = ((SEQ - 1) // CHUNK) * CHUNK

    hp, hs = x_prompt, x_sample
    ak_p, av_p, ak_s, av_s, bv_p, bv_s, cc_p, cc_s = [], [], [], [], [], [], [], []
    for layer in range(DEPTH):
        j = layer // 2
        n_p = rms_norm(hp, norm_mix_g[layer])
        n_s = rms_norm(hs, norm_mix_g[layer])
        if layer % 2 == 0:
            qp, kp, vp, up, vbp = ab_project(n_p, w_in_ab[j], q_norm_g[j], k_norm_g[j], vb_norm_g[j], vb_norm_b[j], pos_p)
            qs, kss, vss, us, vbs = ab_project(n_s, w_in_ab[j], q_norm_g[j], k_norm_g[j], vb_norm_g[j], vb_norm_b[j], pos_s)
            att_p = dilated_attention_prompt(qp, kp, vp).reshape(BATCH, SEQ, A_WIDTH)
            k_all = jnp.concatenate([cache_a_k[j].astype(kss.dtype), kss], axis=1)
            v_all = jnp.concatenate([cache_a_v[j].astype(vss.dtype), vss], axis=1)
            att_s = dilated_attention_sample(qs, k_all, v_all, pos_s, buf_start).reshape(DEC_BATCH, DEC_SEQ, A_WIDTH)
            gate_p = spatial_gate(up, vbp, w_spatial[j], b_spatial[j])
            gate_s = spatial_gate(us, vbs, w_spatial[j], b_spatial[j])
            mix_p = jnp.concatenate([att_p, gate_p], axis=-1) @ w_out_ab[j]
            mix_s = jnp.concatenate([att_s, gate_s], axis=-1) @ w_out_ab[j]
            ak_p.append(kp[:, SEQ - prompt_buf:])
            av_p.append(vp[:, SEQ - prompt_buf:])
            ak_s.append(kss)
            av_s.append(vss)
            bv_p.append(vbp[:, last_chunk_start:])
            bv_s.append(vbs)
        else:
            zero_buf = jnp.zeros((BATCH, CONV_WIDTH - 1, D_CONV), dtype=n_p.dtype)
            mix_p, new_cp = conv_module(n_p, zero_buf, w_c_in[j], w_c_dw[j], b_c_dw[j], c_norm_g[j], c_norm_b[j], w_c_out[j])
            mix_s, new_cs = conv_module(n_s, state_c_conv[j], w_c_in[j], w_c_dw[j], b_c_dw[j], c_norm_g[j], c_norm_b[j], w_c_out[j])
            cc_p.append(new_cp)
            cc_s.append(new_cs)
        hp = hp + mix_p
        hs = hs + mix_s
        hp = hp + ffn(rms_norm(hp, norm_ffn_g[layer]), w_ffn_up[layer], w_ffn_down[layer])
        hs = hs + ffn(rms_norm(hs, norm_ffn_g[layer]), w_ffn_up[layer], w_ffn_down[layer])

    return (hp, hs, jnp.stack(ak_p), jnp.stack(av_p), jnp.stack(ak_s), jnp.stack(av_s),
            jnp.stack(bv_p), jnp.stack(bv_s), jnp.stack(cc_p), jnp.stack(cc_s))
```

```cpp
#include <hip/hip_runtime.h>
#include <hip/hip_cooperative_groups.h>
#include <cstdio>
#include <cstdint>
#include <cmath>
namespace cg = cooperative_groups;
namespace pg8 {
#define PG8_LAS __attribute__((address_space(3)))
typedef unsigned short bf16_t;
typedef short bf16x8 __attribute__((ext_vector_type(8)));
typedef float f32x4 __attribute__((ext_vector_type(4)));
typedef unsigned u32x4 __attribute__((ext_vector_type(4)));
constexpr int BM = 256, BK = 64, HALF = 128, HTB = HALF * BK * 2  , STAGE_BYTES = 8 * HTB, NXCD = 8, WGM = 8;

__host__ __device__ __forceinline__ int lds_byte(int r, int c) { const int st = (r >> 4) * 2 + (c >> 5), rr = r & 15, cc = c & 31, ob = rr * 64 + cc * 2; return st * 1024 + (ob ^ (((ob >> 9) & 1) << 5)); }
__host__ __device__ __forceinline__ void stage_rc(int b, int& R, int& C) { const int st = b / 1024, sb = b % 1024, swz = sb ^ (((sb >> 9) & 1) << 5); R = (st >> 1) * 16 + swz / 64; C = (st & 1) * 32 + (swz % 64) / 2; }
__host__ __device__ __forceinline__ int perm32(int rho) { const int n = rho >> 4, i = rho & 15; return 8 * (i >> 2) + 4 * n + (i & 3); }

struct Unit { int pm, pn; };
struct Gemm { const bf16_t* A; const bf16_t* Bt; int M, N, K; };

struct StaticOrder {
    int nM, nN, nwg, G, c;
    __host__ __device__ void init(int M, int N, int G_, int c_) { nM = M / BM; nN = N / BM; nwg = nM * nN; G = G_; c = c_; }
    __host__ __device__ bool next(int i, Unit& u) const {
        const long L = (long)i * G + c; if (L >= nwg) return false;
        int wgid = (int)L; { const int q = nwg / NXCD, r = nwg % NXCD, xcd = wgid % NXCD, off = wgid / NXCD; wgid = (xcd < r ? xcd * (q + 1) : r * (q + 1) + (xcd - r) * q) + off; }
        const int nig = WGM * nN, gid = wgid / nig, fm = gid * WGM, gsz = (nM - fm) < WGM ? (nM - fm) : WGM;
        u.pm = fm + ((wgid % nig) % gsz); u.pn = (wgid % nig) / gsz; return true;
    }
    __device__ __forceinline__ void a_ready(const Unit&) const {}
    __device__ __forceinline__ void done(const Unit&) const {}
};
typedef float f32x2 __attribute__((ext_vector_type(2)));
typedef __bf16 bf16x2v __attribute__((ext_vector_type(2)));
__device__ __forceinline__ unsigned pkbf(float lo, float hi) { f32x2 v = {lo, hi}; bf16x2v b = __builtin_convertvector(v, bf16x2v); return __builtin_bit_cast(unsigned, b); }
struct EpiAll {
    static constexpr bool PERM = true, AFTER_DRAIN = false;
    int mode; bf16_t* O; int ldc; const float* base; float* out;
    __device__ __forceinline__ void operator()(const f32x4 (&acc)[2][2][4][2], const Unit& u, int wr, int wc, int fr, int fq) const {
        const int row0 = u.pm * BM + wr * 64 + fr;
        if (mode == 3) {
            const int col0 = u.pn * BM + wc * 32 + 8 * fq;
#pragma unroll
            for (int ai = 0; ai < 2; ++ai)
#pragma unroll
                for (int m = 0; m < 4; ++m) { const size_t off = (size_t)(row0 + ai * HALF + m * 16) * ldc + col0;
#pragma unroll
                    for (int bj = 0; bj < 2; ++bj)
#pragma unroll
                        for (int n = 0; n < 2; ++n) { const f32x4 b = *(const f32x4*)(base + off + bj * HALF + n * 4); *(f32x4*)(out + off + bj * HALF + n * 4) = b + acc[ai][bj][m][n]; }
                    asm volatile("" ::: "memory"); }
        } else if (mode == 2) {
            const int col0 = u.pn * HALF + wc * 32 + 8 * fq;
#pragma unroll
            for (int ai = 0; ai < 2; ++ai)
#pragma unroll
                for (int m = 0; m < 4; ++m) { bf16_t* rowp = O + (size_t)(row0 + ai * HALF + m * 16) * ldc + col0;
                    f32x4 x0, x1;
#pragma unroll
                    for (int e = 0; e < 4; ++e) { x0[e] = acc[ai][0][m][0][e] / (1.f + __expf(-acc[ai][1][m][0][e])); x1[e] = acc[ai][0][m][1][e] / (1.f + __expf(-acc[ai][1][m][1][e])); }
                    u32x4 w; w.x = pkbf(x0[0], x0[1]); w.y = pkbf(x0[2], x0[3]); w.z = pkbf(x1[0], x1[1]); w.w = pkbf(x1[2], x1[3]);
                    *(u32x4*)rowp = w; }
        } else {
            const int col0 = u.pn * BM + wc * 32 + 8 * fq;
#pragma unroll
            for (int ai = 0; ai < 2; ++ai)
#pragma unroll
                for (int m = 0; m < 4; ++m) { bf16_t* rowp = O + (size_t)(row0 + ai * HALF + m * 16) * ldc + col0;
#pragma unroll
                    for (int bj = 0; bj < 2; ++bj) { f32x4 v0 = acc[ai][bj][m][0], v1 = acc[ai][bj][m][1];
                        if (mode == 1) {
#pragma unroll
                            for (int e = 0; e < 4; ++e) { const float a = fmaxf(v0[e], 0.f), b = fmaxf(v1[e], 0.f); v0[e] = a * a; v1[e] = b * b; } }
                        u32x4 w; w.x = pkbf(v0[0], v0[1]); w.y = pkbf(v0[2], v0[3]); w.z = pkbf(v1[0], v1[1]); w.w = pkbf(v1[2], v1[3]);
                        *(u32x4*)(rowp + bj * HALF) = w; } }
        }
    }
};
template <class Epi, class Sched, bool ALIGN_EPI = false, bool SP2 = false>
__device__ __forceinline__ void gemm_phase(PG8_LAS unsigned char* lds, const Gemm g, const Sched& S, const Epi& E, const int tid_in) {
    const int tid = tid_in, wid = __builtin_amdgcn_readfirstlane(tid >> 6), lane = tid & 63, wr = wid >> 2, wc = wid & 3, fr = lane & 15, fq = lane >> 4;
    const int K = g.K, nt = K / BK;
    unsigned voffA[2], voffB[2];
#pragma unroll
    for (int i = 0; i < 2; ++i) { int R, C; stage_rc(tid * 16 + i * 8192, R, C); const int Rb = Epi::PERM ? ((R & ~31) + perm32(R & 31)) : R;
        voffA[i] = (unsigned)(R * K + C) * 2u; voffB[i] = (unsigned)(Rb * K + C) * 2u; }
    const size_t kstep = (size_t)(BK * 2);
    const size_t hstep = (size_t)HALF * K * 2;
    const size_t tstep = 2 * hstep;
    const unsigned ldsw = (unsigned)wid * 1024u;
    const int aoff = lds_byte(wr * 64 + fr, fq * 8), boff = lds_byte(wc * 32 + fr, fq * 8);
#define PG8_SA(b, h) (((b) * 2 + (h)) * HTB)
#define PG8_SB(b, h) ((4 + (b) * 2 + (h)) * HTB)
#define PG8_STAGE(bufoff, gbase, voff) do { _Pragma("unroll") for (int _i = 0; _i < 2; ++_i) \
        __builtin_amdgcn_global_load_lds((const unsigned*)((const char*)(gbase) + (voff)[_i]), (PG8_LAS unsigned*)(lds + (bufoff) + ldsw + _i * 8192), 16, 0, 0); } while (0)
#define PG8_LDA(dst, b, h) do { _Pragma("unroll") for (int m = 0; m < 4; ++m) _Pragma("unroll") for (int k = 0; k < 2; ++k) dst[m][k] = *(const PG8_LAS bf16x8*)(lds + PG8_SA(b, h) + aoff + m * 2048 + k * 1024); } while (0)
#define PG8_LDB(dst, b, h) do { _Pragma("unroll") for (int n = 0; n < 2; ++n) _Pragma("unroll") for (int k = 0; k < 2; ++k) dst[n][k] = *(const PG8_LAS bf16x8*)(lds + PG8_SB(b, h) + boff + n * 2048 + k * 1024); } while (0)
#define PG8_MMA(ai, bj, At, Bt) do { __builtin_amdgcn_s_setprio(1); _Pragma("unroll") for (int m = 0; m < 4; ++m) _Pragma("unroll") for (int n = 0; n < 2; ++n) _Pragma("unroll") for (int k = 0; k < 2; ++k) \
        acc[ai][bj][m][n] = __builtin_amdgcn_mfma_f32_16x16x32_bf16(Bt[n][k], At[m][k], acc[ai][bj][m][n], 0, 0, 0); __builtin_amdgcn_s_setprio(0); } while (0)
#define PG8_WAIT_V(n) asm volatile("s_waitcnt vmcnt(" #n ")" ::: "memory")
#define PG8_WAIT_L(n) asm volatile("s_waitcnt lgkmcnt(" #n ")" ::: "memory")
#define PG8_BAR __builtin_amdgcn_s_barrier()
#define PG8_SCHED __builtin_amdgcn_sched_barrier(0)
    Unit cur, nxt; int ui = 0;
    if (!S.next(0, cur)) return;
    f32x4 acc[2][2][4][2];
#pragma unroll
    for (int a = 0; a < 2; ++a)
#pragma unroll
        for (int b = 0; b < 2; ++b)
#pragma unroll
            for (int m = 0; m < 4; ++m)
#pragma unroll
                for (int n = 0; n < 2; ++n) acc[a][b][m][n] = (f32x4){0.f, 0.f, 0.f, 0.f};
    bf16x8 At[4][2], B0[2][2], B1[2][2];
    const char* cA = (const char*)g.A + (size_t)cur.pm * tstep; const char* cB = (const char*)g.Bt + (size_t)cur.pn * tstep;
    S.a_ready(cur);
    if constexpr (SP2) {
        PG8_STAGE(PG8_SB(0, 0), cB, voffB); PG8_STAGE(PG8_SB(0, 1), cB + hstep, voffB); PG8_STAGE(PG8_SA(0, 0), cA, voffA); PG8_STAGE(PG8_SA(0, 1), cA + hstep, voffA);
        if (wr == 1) PG8_BAR;
        PG8_WAIT_V(2); PG8_BAR;
        PG8_STAGE(PG8_SB(1, 0), cB + kstep, voffB); PG8_STAGE(PG8_SA(1, 0), cA + kstep, voffA); PG8_STAGE(PG8_SB(1, 1), cB + hstep + kstep, voffB);
        PG8_WAIT_V(6); PG8_BAR;
    } else {
        PG8_STAGE(PG8_SB(0, 0), cB, voffB); PG8_STAGE(PG8_SA(0, 0), cA, voffA); PG8_STAGE(PG8_SB(0, 1), cB + hstep, voffB); PG8_STAGE(PG8_SA(0, 1), cA + hstep, voffA);
        if (wr == 1) PG8_BAR;
        PG8_WAIT_V(4); PG8_BAR;
        PG8_STAGE(PG8_SB(1, 0), cB + kstep, voffB); PG8_STAGE(PG8_SA(1, 0), cA + kstep, voffA); PG8_STAGE(PG8_SB(1, 1), cB + hstep + kstep, voffB);
        PG8_WAIT_V(6); PG8_BAR;
    }
    for (;;) {
        const bool has_next = S.next(ui + 1, nxt);
        const char* nA = has_next ? (const char*)g.A + (size_t)nxt.pm * tstep : cA; const char* nB = has_next ? (const char*)g.Bt + (size_t)nxt.pn * tstep : cB;
        for (int t = 0; t < nt; t += 2) {
            const bool last = (t == nt - 2);
            const char* a1 = cA + (size_t)(t + 1) * kstep;
            const char* a2 = last ? nA : cA + (size_t)(t + 2) * kstep; const char* b2 = last ? nB : cB + (size_t)(t + 2) * kstep;
            const char* a3 = a2 + kstep; const char* b3 = b2 + kstep;
            if (last && has_next) S.a_ready(nxt);
            if constexpr (SP2) {
            PG8_LDB(B0, 0, 0); PG8_LDB(B1, 0, 1); PG8_SCHED; PG8_LDA(At, 0, 0); PG8_STAGE(PG8_SA(1, 1), a1 + hstep, voffA);
            PG8_WAIT_V(8); PG8_WAIT_L(0); PG8_BAR; PG8_MMA(0, 0, At, B0); PG8_MMA(0, 1, At, B1); PG8_BAR; PG8_SCHED;
            PG8_LDA(At, 0, 1); PG8_STAGE(PG8_SB(0, 0), b2, voffB); PG8_STAGE(PG8_SB(0, 1), b2 + hstep, voffB); PG8_STAGE(PG8_SA(0, 0), a2, voffA);
            PG8_WAIT_V(8); PG8_WAIT_L(0); PG8_BAR; PG8_MMA(1, 0, At, B0); PG8_MMA(1, 1, At, B1); PG8_BAR; PG8_SCHED;
            PG8_LDB(B0, 1, 0); PG8_LDB(B1, 1, 1); PG8_SCHED; PG8_LDA(At, 1, 0); PG8_STAGE(PG8_SA(0, 1), a2 + hstep, voffA);
            PG8_WAIT_V(8); PG8_WAIT_L(0); PG8_BAR; PG8_MMA(0, 0, At, B0); PG8_MMA(0, 1, At, B1); PG8_BAR; PG8_SCHED;
            PG8_LDA(At, 1, 1); PG8_STAGE(PG8_SB(1, 0), b3, voffB); PG8_STAGE(PG8_SB(1, 1), b3 + hstep, voffB); PG8_STAGE(PG8_SA(1, 0), a3, voffA);
            PG8_WAIT_V(8); PG8_WAIT_L(0); PG8_BAR; PG8_MMA(1, 0, At, B0); PG8_MMA(1, 1, At, B1); PG8_BAR; PG8_SCHED;
            } else {
            PG8_LDB(B0, 0, 0); PG8_SCHED; PG8_LDA(At, 0, 0); PG8_STAGE(PG8_SA(1, 1), a1 + hstep, voffA);
            PG8_WAIT_L(8); PG8_BAR; PG8_WAIT_L(0); PG8_MMA(0, 0, At, B0); PG8_BAR; PG8_SCHED;
            PG8_LDB(B1, 0, 1); PG8_STAGE(PG8_SB(0, 0), b2, voffB);
            PG8_BAR; PG8_WAIT_L(0); PG8_MMA(0, 1, At, B1); PG8_BAR;
            PG8_LDA(At, 0, 1); PG8_STAGE(PG8_SA(0, 0), a2, voffA);
            PG8_BAR; PG8_WAIT_L(0); PG8_MMA(1, 0, At, B0); PG8_BAR; PG8_SCHED;
            PG8_STAGE(PG8_SB(0, 1), b2 + hstep, voffB);
            PG8_WAIT_V(6); PG8_BAR; PG8_MMA(1, 1, At, B1); PG8_BAR;
            PG8_LDB(B0, 1, 0); PG8_SCHED; PG8_LDA(At, 1, 0); PG8_STAGE(PG8_SA(0, 1), a2 + hstep, voffA);
            PG8_WAIT_L(8); PG8_BAR; PG8_WAIT_L(0); PG8_MMA(0, 0, At, B0); PG8_BAR; PG8_SCHED;
            PG8_LDB(B1, 1, 1); PG8_STAGE(PG8_SB(1, 0), b3, voffB);
            PG8_BAR; PG8_WAIT_L(0); PG8_MMA(0, 1, At, B1); PG8_BAR;
            PG8_LDA(At, 1, 1); PG8_STAGE(PG8_SA(1, 0), a3, voffA);
            PG8_BAR; PG8_WAIT_L(0); PG8_MMA(1, 0, At, B0); PG8_BAR; PG8_SCHED;
            PG8_STAGE(PG8_SB(1, 1), b3 + hstep, voffB);
            PG8_WAIT_V(6); PG8_BAR; PG8_MMA(1, 1, At, B1); PG8_BAR;
            }
        }
        if constexpr (ALIGN_EPI) { if (wr == 0) PG8_BAR; }
        if constexpr (!Epi::AFTER_DRAIN) { int fr2 = fr, fq2 = fq; asm volatile("" : "+v"(fr2), "+v"(fq2));   E(acc, cur, wr, wc, fr2, fq2); S.done(cur); }
        if (!has_next) break;
#pragma unroll
        for (int a = 0; a < 2; ++a)
#pragma unroll
            for (int b = 0; b < 2; ++b)
#pragma unroll
                for (int m = 0; m < 4; ++m)
#pragma unroll
                    for (int n = 0; n < 2; ++n) acc[a][b][m][n] = (f32x4){0.f, 0.f, 0.f, 0.f};
        cur = nxt; cA = nA; cB = nB; ++ui;
        if constexpr (ALIGN_EPI) { if (wr == 1) PG8_BAR; }
    }
    PG8_WAIT_V(0);
    if constexpr (!ALIGN_EPI) { if (wr == 0) PG8_BAR; }
    PG8_BAR;
    if constexpr (Epi::AFTER_DRAIN) { E.fused(acc, cur, wr, wc, fr, fq, lds, wid, lane); S.done(cur); }
#undef PG8_SA
#undef PG8_SB
#undef PG8_STAGE
#undef PG8_LDA
#undef PG8_LDB
#undef PG8_MMA
#undef PG8_WAIT_V
#undef PG8_WAIT_L
#undef PG8_BAR
#undef PG8_SCHED
}
}
#define LAS __attribute__((address_space(3)))
typedef unsigned short bf16;
typedef short bf16x8 __attribute__((ext_vector_type(8)));
typedef short s16x4 __attribute__((ext_vector_type(4)));
typedef float f32x4 __attribute__((ext_vector_type(4)));
typedef unsigned u32x4 __attribute__((ext_vector_type(4)));
typedef unsigned u32x2 __attribute__((ext_vector_type(2)));

constexpr int DM = 1024, MP = 16384, MS = 32, MT = MP + MS, MPAD = 16640, SEQ = 2048, NB = 8;
constexpr int ZW = 2560, FF = 4096;
constexpr float EPS = 1e-6f;
constexpr size_t O_YP = 0, O_YS = 16777216, O_AKP = 16809984, O_AVP = 33587200, O_AKS = 50364416, O_AVS = 50397184,
                 O_BVP = 50429952, O_BVS = 51478528, O_CCP = 51511296, O_CCS = 52002816, O_END = 53968896;
constexpr size_t MiB = 1u << 20;
constexpr size_t WS_ROPE = 1 * MiB, WS_WSP = 2 * MiB, WS_ZS = 3 * MiB;
constexpr size_t WS_WUP = 8 * MiB, WS_WDN = 40 * MiB, WS_WIN = 72 * MiB, WS_WOUT = 82 * MiB, WS_WCI = 86 * MiB, WS_WCO = 94 * MiB;
constexpr size_t WS_N = 100 * MiB, WS_Z = 134 * MiB, WS_Q = 216 * MiB, WS_K = 233 * MiB, WS_V = 250 * MiB, WS_U = 267 * MiB, WS_VB = 284 * MiB;
constexpr size_t WS_OP = 301 * MiB, WS_LP = 350 * MiB, WS_CAT = 352 * MiB, WS_HID = 386 * MiB, WS_X = 516 * MiB, WS_Y = 550 * MiB, WS_END = 584 * MiB;
constexpr int LDS_BYTES = 147456;

struct Args { const float* in[23]; float* out; unsigned char* ws; int ph_lo, ph_hi; };
enum { I_XP = 0, I_XS, I_CK, I_CV, I_CST, I_GMIX, I_GFFN, I_WUP, I_WDN, I_WIN, I_QG, I_KG, I_VBG, I_VBB, I_WSP, I_BSP, I_WOUT, I_WCI, I_WDW, I_BDW, I_CG, I_CB, I_WCO };

__device__ __forceinline__ float wave_sum(float v) {
#pragma unroll
    for (int o = 1; o < 64; o <<= 1) v += __shfl_xor(v, o);
    return v;
}
__device__ __forceinline__ float wave_max(float v) {
#pragma unroll
    for (int o = 1; o < 64; o <<= 1) v = fmaxf(v, __shfl_xor(v, o));
    return v;
}
__device__ __forceinline__ float bflo(unsigned u) { return __uint_as_float(u << 16); }
__device__ __forceinline__ float bfhi(unsigned u) { return __uint_as_float(u & 0xffff0000u); }
__device__ __forceinline__ unsigned f2bf(float f) { unsigned u = __float_as_uint(f); return (u + 0x7fffu + ((u >> 16) & 1u)) >> 16; }
__device__ __forceinline__ unsigned pk2(float lo, float hi) { return pg8::pkbf(lo, hi); }
__device__ __forceinline__ float gelu_tanh(float x) {
    const float y = 0.7978845608028654f * (x + 0.044715f * x * x * x);
    const float t = 1.f - 2.f / (__expf(2.f * y) + 1.f);
    return 0.5f * x * (1.f + t);
}

__device__ __forceinline__ void transpose_item(const float* W, int K, int N, bf16* WT, bool glu, LAS float* scr, int item, int lane) {
    const int nblk = N / 32, kb = item / nblk, nb = item % nblk, k0 = 64 * kb, n0 = 32 * nb;
#pragma unroll 8
    for (int i = 0; i < 32; ++i) { const int kk = 2 * i + (lane >> 5); scr[kk * 33 + (lane & 31)] = W[(size_t)(k0 + kk) * N + n0 + (lane & 31)]; }
    asm volatile("s_waitcnt lgkmcnt(0)" ::: "memory");
    const int d0 = glu ? (256 * ((n0 & 1023) >> 7) + 128 * (n0 >> 10) + (n0 & 127)) : n0;
    const int c = lane & 7;
#pragma unroll
    for (int j = 0; j < 4; ++j) { const int n = (lane >> 3) + 8 * j; const LAS float* s = scr + (8 * c) * 33 + n;
        u32x4 o; o.x = pk2(s[0 * 33], s[1 * 33]); o.y = pk2(s[2 * 33], s[3 * 33]); o.z = pk2(s[4 * 33], s[5 * 33]); o.w = pk2(s[6 * 33], s[7 * 33]);
        *(u32x4*)(WT + (size_t)(d0 + n) * K + k0 + 8 * c) = o; }
    asm volatile("s_waitcnt lgkmcnt(0)" ::: "memory");
}

__device__ __forceinline__ void prologue(const Args& a, LAS unsigned char* lds, int tid, int wid, int lane) {
    unsigned char* ws = a.ws;
    LAS float* scr = (LAS float*)(lds + wid * 16384);
    const int gw = blockIdx.x * 8 + wid, NGW = gridDim.x * 8;
    constexpr int I_UP = 16 * 128, I_DN = 64 * 32, I_IN = 16 * 80, I_OUT = 16 * 32, I_CI = 16 * 64, I_CO = 16 * 32;
    constexpr int T_UP = 4 * I_UP, T_DN = 4 * I_DN, T_IN = 2 * I_IN, T_OUT = 2 * I_OUT, T_CI = 2 * I_CI, T_CO = 2 * I_CO;
    constexpr int NITEMS = T_UP + T_DN + T_IN + T_OUT + T_CI + T_CO;
    for (int it = gw; it < NITEMS; it += NGW) {
        int r = it;
        if (r < T_UP) { const int l = r / I_UP; transpose_item(a.in[I_WUP] + (size_t)l * DM * FF, DM, FF, (bf16*)(ws + WS_WUP) + (size_t)l * DM * FF, false, scr, r % I_UP, lane); continue; } r -= T_UP;
        if (r < T_DN) { const int l = r / I_DN; transpose_item(a.in[I_WDN] + (size_t)l * DM * FF, FF, DM, (bf16*)(ws + WS_WDN) + (size_t)l * DM * FF, false, scr, r % I_DN, lane); continue; } r -= T_DN;
        if (r < T_IN) { const int l = r / I_IN; transpose_item(a.in[I_WIN] + (size_t)l * DM * ZW, DM, ZW, (bf16*)(ws + WS_WIN) + (size_t)l * DM * ZW, false, scr, r % I_IN, lane); continue; } r -= T_IN;
        if (r < T_OUT) { const int l = r / I_OUT; transpose_item(a.in[I_WOUT] + (size_t)l * DM * DM, DM, DM, (bf16*)(ws + WS_WOUT) + (size_t)l * DM * DM, false, scr, r % I_OUT, lane); continue; } r -= T_OUT;
        if (r < T_CI) { const int l = r / I_CI; transpose_item(a.in[I_WCI] + (size_t)l * DM * 2048, DM, 2048, (bf16*)(ws + WS_WCI) + (size_t)l * DM * 2048, true, scr, r % I_CI, lane); continue; } r -= T_CI;
        { const int l = r / I_CO; transpose_item(a.in[I_WCO] + (size_t)l * DM * DM, DM, DM, (bf16*)(ws + WS_WCO) + (size_t)l * DM * DM, false, scr, r % I_CO, lane); }
    }
    const int gt = blockIdx.x * 512 + tid, NGT = gridDim.x * 512;
    for (int e = gt; e < 2049 * 32; e += NGT) {
        const int pi = e >> 5, i = e & 31; const float pos = (pi < 2048) ? (float)pi : 8192.f;
        const float inv = powf(10000.f, -(float)i / 32.f);
        const float ang = pos * inv;
        double rev = (double)ang * 0.15915494309189533577; rev -= floor(rev);
        const float fr = (float)rev;
        float2 cs; cs.x = __builtin_amdgcn_cosf(fr); cs.y = __builtin_amdgcn_sinf(fr);
        ((float2*)(ws + WS_ROPE))[e] = cs;
    }
    for (int e = gt; e < 2 * 8 * 128 * 128; e += NGT) {
        const int jj = e & 127, i = (e >> 7) & 127; const float w = (jj <= i) ? a.in[I_WSP][e] : 0.f;
        ((bf16*)(ws + WS_WSP))[e] = (bf16)f2bf(w);
    }
}

__device__ __forceinline__ void norm_phase(const float* hp, const float* hs, const float* g, bf16* nout, int wid, int lane) {
    const int gw = blockIdx.x * 8 + wid, NGW = gridDim.x * 8;
    f32x4 gv[4];
#pragma unroll
    for (int j = 0; j < 4; ++j) gv[j] = *(const f32x4*)(g + 4 * lane + 256 * j);
    for (int row = gw; row < MT; row += NGW) {
        const float* src = (row < MP) ? hp + (size_t)row * DM : hs + (size_t)(row - MP) * DM;
        f32x4 v[4]; float s = 0.f;
#pragma unroll
        for (int j = 0; j < 4; ++j) { v[j] = *(const f32x4*)(src + 4 * lane + 256 * j); s += (v[j].x * v[j].x + v[j].y * v[j].y) + (v[j].z * v[j].z + v[j].w * v[j].w); }
        const float r = rsqrtf(wave_sum(s) * (1.f / DM) + EPS);
        bf16* dst = nout + (size_t)row * DM;
#pragma unroll
        for (int j = 0; j < 4; ++j) { u32x2 o; o.x = pk2(v[j].x * r * gv[j].x, v[j].y * r * gv[j].y); o.y = pk2(v[j].z * r * gv[j].z, v[j].w * r * gv[j].w); *(u32x2*)(dst + 4 * lane + 256 * j) = o; }
    }
}

__device__ __forceinline__ void post_phase(const Args& a, int jl, int wid, int lane) {
    unsigned char* ws = a.ws;
    const bf16* Z = (const bf16*)(ws + WS_Z);
    bf16* Qb = (bf16*)(ws + WS_Q); bf16* Kb = (bf16*)(ws + WS_K); bf16* Vb = (bf16*)(ws + WS_V); bf16* Ub = (bf16*)(ws + WS_U); bf16* VBb = (bf16*)(ws + WS_VB);
    const float2* rope = (const float2*)(ws + WS_ROPE);
    const int gw = blockIdx.x * 8 + wid, NGW = gridDim.x * 8;
    const int hh = lane >> 3, sub = lane & 7;
    for (int row = gw; row < MT; row += NGW) {
        const bool samp = row >= MP; const int t = row & (SEQ - 1), bb = row >> 11, ns = row - MP;
        const int pidx = samp ? 2048 : t;
        const bf16* z = Z + (size_t)row * ZW;
        float cs[4], sn[4];
#pragma unroll
        for (int i = 0; i < 4; ++i) { const float2 c2 = rope[pidx * 32 + sub * 4 + i]; cs[i] = c2.x; sn[i] = c2.y; }
#pragma unroll
        for (int which = 0; which < 2; ++which) {
            const bf16* src = z + which * 512 + hh * 64 + sub * 4;
            const u32x2 lo = *(const u32x2*)src, hi = *(const u32x2*)(src + 32);
            float x1[4] = {bflo(lo.x), bfhi(lo.x), bflo(lo.y), bfhi(lo.y)}, x2[4] = {bflo(hi.x), bfhi(hi.x), bflo(hi.y), bfhi(hi.y)};
            float ss = 0.f;
#pragma unroll
            for (int i = 0; i < 4; ++i) ss += x1[i] * x1[i] + x2[i] * x2[i];
            ss += __shfl_xor(ss, 1); ss += __shfl_xor(ss, 2); ss += __shfl_xor(ss, 4);
            const float r = rsqrtf(ss * (1.f / 64.f) + EPS);
            const float* g = a.in[which ? I_KG : I_QG] + jl * 64;
            const f32x4 g1 = *(const f32x4*)(g + sub * 4), g2 = *(const f32x4*)(g + 32 + sub * 4);
            f32x4 o1, o2;
#pragma unroll
            for (int i = 0; i < 4; ++i) { const float y1 = x1[i] * r * g1[i], y2 = x2[i] * r * g2[i]; o1[i] = y1 * cs[i] - y2 * sn[i]; o2[i] = y2 * cs[i] + y1 * sn[i]; }
            bf16* dst = (which ? Kb : Qb) + (size_t)row * 512 + hh * 64 + sub * 4;
            u32x2 p1, p2; p1.x = pk2(o1[0], o1[1]); p1.y = pk2(o1[2], o1[3]); p2.x = pk2(o2[0], o2[1]); p2.y = pk2(o2[2], o2[3]);
            *(u32x2*)dst = p1; *(u32x2*)(dst + 32) = p2;
            if (which == 1) {
                float* ok = samp ? a.out + O_AKS + (size_t)(jl * MS + ns) * 512 : a.out + O_AKP + ((size_t)jl * MP + row) * 512;
                *(f32x4*)(ok + hh * 64 + sub * 4) = o1; *(f32x4*)(ok + hh * 64 + 32 + sub * 4) = o2;
            }
        }
        {
            const u32x4 vv = *(const u32x4*)(z + 1024 + lane * 8);
            *(u32x4*)(Vb + (size_t)row * 512 + lane * 8) = vv;
            float* ov = samp ? a.out + O_AVS + (size_t)(jl * MS + ns) * 512 : a.out + O_AVP + ((size_t)jl * MP + row) * 512;
            *(f32x4*)(ov + lane * 8) = (f32x4){bflo(vv.x), bfhi(vv.x), bflo(vv.y), bfhi(vv.y)};
            *(f32x4*)(ov + lane * 8 + 4) = (f32x4){bflo(vv.z), bfhi(vv.z), bflo(vv.w), bfhi(vv.w)};
        }
        {
            const u32x4 uv = *(const u32x4*)(z + 1536 + lane * 8);
            u32x4 o; o.x = pk2(gelu_tanh(bflo(uv.x)), gelu_tanh(bfhi(uv.x))); o.y = pk2(gelu_tanh(bflo(uv.y)), gelu_tanh(bfhi(uv.y)));
            o.z = pk2(gelu_tanh(bflo(uv.z)), gelu_tanh(bfhi(uv.z))); o.w = pk2(gelu_tanh(bflo(uv.w)), gelu_tanh(bfhi(uv.w)));
            *(u32x4*)(Ub + (size_t)row * 512 + lane * 8) = o;
        }
        {
            const u32x4 bv = *(const u32x4*)(z + 2048 + lane * 8);
            float x[8] = {gelu_tanh(bflo(bv.x)), gelu_tanh(bfhi(bv.x)), gelu_tanh(bflo(bv.y)), gelu_tanh(bfhi(bv.y)), gelu_tanh(bflo(bv.z)), gelu_tanh(bfhi(bv.z)), gelu_tanh(bflo(bv.w)), gelu_tanh(bfhi(bv.w))};
            float s = 0.f;
#pragma unroll
            for (int i = 0; i < 8; ++i) s += x[i];
            const float mean = wave_sum(s) * (1.f / 512.f); float q = 0.f;
#pragma unroll
            for (int i = 0; i < 8; ++i) { x[i] -= mean; q += x[i] * x[i]; }
            const float rstd = rsqrtf(wave_sum(q) * (1.f / 512.f) + EPS);
            const float* g = a.in[I_VBG] + jl * 512 + lane * 8; const float* be = a.in[I_VBB] + jl * 512 + lane * 8;
            const f32x4 ga = *(const f32x4*)g, gb = *(const f32x4*)(g + 4), ba = *(const f32x4*)be, bb4 = *(const f32x4*)(be + 4);
            f32x4 ya, yb;
#pragma unroll
            for (int i = 0; i < 4; ++i) { ya[i] = x[i] * rstd * ga[i] + ba[i]; yb[i] = x[4 + i] * rstd * gb[i] + bb4[i]; }
            u32x4 o; o.x = pk2(ya[0], ya[1]); o.y = pk2(ya[2], ya[3]); o.z = pk2(yb[0], yb[1]); o.w = pk2(yb[2], yb[3]);
            *(u32x4*)(VBb + (size_t)row * 512 + lane * 8) = o;
            float* ob = nullptr;
            if (samp) ob = a.out + O_BVS + (size_t)(jl * MS + ns) * 512;
            else if (t >= 1920) ob = a.out + O_BVP + ((size_t)(jl * NB + bb) * 128 + (t - 1920)) * 512;
            if (ob) { *(f32x4*)(ob + lane * 8) = ya; *(f32x4*)(ob + lane * 8 + 4) = yb; }
        }
    }
}

__device__ __forceinline__ void combine_phase(const Args& a, int wid, int lane) {
    unsigned char* ws = a.ws;
    const bf16* OP = (const bf16*)(ws + WS_OP); const float* LP = (const float*)(ws + WS_LP); bf16* CAT = (bf16*)(ws + WS_CAT);
    const int gw = blockIdx.x * 8 + wid, NGW = gridDim.x * 8; const int hh = lane >> 3;
    for (int row = gw; row < MP; row += NGW) {
        const float l0 = LP[((size_t)0 * MPAD + row) * 8 + hh], l1 = LP[((size_t)1 * MPAD + row) * 8 + hh], l2 = LP[((size_t)2 * MPAD + row) * 8 + hh];
        const float m = fmaxf(l0, fmaxf(l1, l2)); float e0 = __expf(l0 - m), e1 = __expf(l1 - m), e2 = __expf(l2 - m); const float inv = 1.f / (e0 + e1 + e2);
        e0 *= inv; e1 *= inv; e2 *= inv;
        const u32x4 p0 = *(const u32x4*)(OP + ((size_t)0 * MPAD + row) * 512 + lane * 8), p1 = *(const u32x4*)(OP + ((size_t)1 * MPAD + row) * 512 + lane * 8), p2 = *(const u32x4*)(OP + ((size_t)2 * MPAD + row) * 512 + lane * 8);
        u32x4 o;
#pragma unroll
        for (int i = 0; i < 4; ++i) { const float lo = e0 * bflo(p0[i]) + e1 * bflo(p1[i]) + e2 * bflo(p2[i]), hi = e0 * bfhi(p0[i]) + e1 * bfhi(p1[i]) + e2 * bfhi(p2[i]); o[i] = pk2(lo, hi); }
        *(u32x4*)(CAT + (size_t)row * DM + lane * 8) = o;
    }
}
constexpr int TS = 144;
constexpr int LDS_KT = 0, LDS_VT = 256 * TS;
__device__ __forceinline__ s16x4 tr_read(LAS unsigned char* p) { return __builtin_bit_cast(s16x4, __builtin_amdgcn_ds_read_tr16_b64_v4i16((LAS s16x4*)p)); }
#define MFMA16(x, y, c) __builtin_amdgcn_mfma_f32_16x16x32_bf16((x), (y), (c), 0, 0, 0)

__device__ __forceinline__ void attn_unit(const Args& a, LAS unsigned char* lds, int unit, int tid, int wid, int lane) {
    unsigned char* ws = a.ws;
    const bf16* Qb = (const bf16*)(ws + WS_Q); const bf16* Kb = (const bf16*)(ws + WS_K); const bf16* Vb = (const bf16*)(ws + WS_V);
    bf16* OP = (bf16*)(ws + WS_OP); float* LP = (float*)(ws + WS_LP);
    const int fr = lane & 15, fq = lane >> 4;
    const int br = unit >> 10, rem = unit & 1023, bh = rem >> 4, idx = rem & 15, b = bh >> 3, h = bh & 7;
    const int dsh = 2 * br, nbm = (16 >> dsh) - 1, res = idx >> (4 - dsh), qb = idx & nbm;
    const size_t rowb = (size_t)b * SEQ + res;
#pragma unroll
    for (int it = 0; it < 4; ++it) {
        const int c = tid + 512 * it, kr = c >> 3, ch = c & 7, s = 128 * (qb - 1) + kr;
        u32x4 kv = {0u, 0u, 0u, 0u}, vv = {0u, 0u, 0u, 0u};
        if (s >= 0) { const size_t row = rowb + ((size_t)s << dsh); kv = *(const u32x4*)(Kb + row * 512 + h * 64 + ch * 8); vv = *(const u32x4*)(Vb + row * 512 + h * 64 + ch * 8); }
        *(LAS u32x4*)(lds + LDS_KT + kr * TS + ch * 16) = kv; *(LAS u32x4*)(lds + LDS_VT + kr * TS + ch * 16) = vv;
    }
    const int sq = 128 * qb + 16 * wid + fr; const size_t rowq = rowb + ((size_t)sq << dsh);
    const bf16x8 qf0 = *(const bf16x8*)(Qb + rowq * 512 + h * 64 + fq * 8), qf1 = *(const bf16x8*)(Qb + rowq * 512 + h * 64 + 32 + fq * 8);
    __syncthreads();
    f32x4 S[10];
#pragma unroll
    for (int kp = 0; kp < 9; ++kp) {
        const int kt = wid + kp; LAS unsigned char* ka = lds + LDS_KT + (16 * kt + fr) * TS + fq * 16;
        const bf16x8 x0 = *(const LAS bf16x8*)ka, x1 = *(const LAS bf16x8*)(ka + 64);
        f32x4 acc = {0.f, 0.f, 0.f, 0.f};
        acc = MFMA16(x0, qf0, acc); acc = MFMA16(x1, qf1, acc); S[kp] = acc;
    }
    float mx = -INFINITY;
#pragma unroll
    for (int kp = 0; kp < 9; ++kp)
#pragma unroll
        for (int v = 0; v < 4; ++v) {
            const int dist = 128 + fr - 16 * kp - 4 * fq - v; bool ok = (dist >= 0) && (dist <= 128);
            if (qb == 0 && (wid + kp) < 8) ok = false;
            const float sc = ok ? S[kp][v] * 0.125f : -INFINITY; S[kp][v] = sc; mx = fmaxf(mx, sc);
        }
    mx = fmaxf(mx, __shfl_xor(mx, 16)); mx = fmaxf(mx, __shfl_xor(mx, 32));
    float den = 0.f;
#pragma unroll
    for (int kp = 0; kp < 9; ++kp)
#pragma unroll
        for (int v = 0; v < 4; ++v) { const float p = __expf(S[kp][v] - mx); S[kp][v] = p; den += p; }
    den += __shfl_xor(den, 16); den += __shfl_xor(den, 32);
    S[9] = (f32x4){0.f, 0.f, 0.f, 0.f};
    f32x4 O[4];
#pragma unroll
    for (int dt = 0; dt < 4; ++dt) O[dt] = (f32x4){0.f, 0.f, 0.f, 0.f};
#pragma unroll
    for (int j = 0; j < 5; ++j) {
        u32x4 pw; pw.x = pk2(S[2 * j][0], S[2 * j][1]); pw.y = pk2(S[2 * j][2], S[2 * j][3]); pw.z = pk2(S[2 * j + 1][0], S[2 * j + 1][1]); pw.w = pk2(S[2 * j + 1][2], S[2 * j + 1][3]);
        const bf16x8 pf = __builtin_bit_cast(bf16x8, pw);
        const int kta = wid + 2 * j; int ktb = kta + 1; ktb = ktb > 15 ? 15 : ktb;
        LAS unsigned char* va = lds + LDS_VT + (16 * kta + 4 * fq + (fr >> 2)) * TS + (fr & 3) * 8;
        LAS unsigned char* vb = lds + LDS_VT + (16 * ktb + 4 * fq + (fr >> 2)) * TS + (fr & 3) * 8;
#pragma unroll
        for (int dt = 0; dt < 4; ++dt) {
            const s16x4 xa = tr_read(va + dt * 32), xb = tr_read(vb + dt * 32);
            const bf16x8 xf = __builtin_shufflevector(xa, xb, 0, 1, 2, 3, 4, 5, 6, 7);
            O[dt] = MFMA16(xf, pf, O[dt]);
        }
    }
    const float rden = 1.f / den;
    bf16* op = OP + ((size_t)br * MPAD + rowq) * 512 + h * 64 + 4 * fq;
#pragma unroll
    for (int dt = 0; dt < 4; ++dt) { u32x2 o; o.x = pk2(O[dt][0] * rden, O[dt][1] * rden); o.y = pk2(O[dt][2] * rden, O[dt][3] * rden); *(u32x2*)(op + 16 * dt) = o; }
    if (fq == 0) LP[((size_t)br * MPAD + rowq) * 8 + h] = mx + __logf(den);
}

__device__ __forceinline__ void spatial_unit(const Args& a, LAS unsigned char* lds, int unit, int jl, int tid, int wid, int lane) {
    unsigned char* ws = a.ws;
    const bf16* VBb = (const bf16*)(ws + WS_VB); const bf16* Ub = (const bf16*)(ws + WS_U); const bf16* WSP = (const bf16*)(ws + WS_WSP); bf16* CAT = (bf16*)(ws + WS_CAT);
    const int fr = lane & 15, fq = lane >> 4;
    const int b = unit >> 7, c = (unit >> 3) & 15, g = unit & 7;
    const size_t r0 = (size_t)b * SEQ + c * 128;
#pragma unroll
    for (int it = 0; it < 2; ++it) {
        const int cc = tid + 512 * it, kr = cc >> 3, ch = cc & 7;
        *(LAS u32x4*)(lds + LDS_VT + kr * TS + ch * 16) = *(const u32x4*)(VBb + (r0 + kr) * 512 + g * 64 + ch * 8);
    }
    __syncthreads();
    const int i = 16 * wid + fr;
    const bf16* wrow = WSP + ((size_t)(jl * 8 + g) * 128 + i) * 128;
    f32x4 O[4];
#pragma unroll
    for (int dt = 0; dt < 4; ++dt) O[dt] = (f32x4){0.f, 0.f, 0.f, 0.f};
    const int nks = (wid >> 1) + 1;
    for (int js = 0; js < nks; ++js) {
        const u32x2 wa = *(const u32x2*)(wrow + 32 * js + 4 * fq), wb = *(const u32x2*)(wrow + 32 * js + 16 + 4 * fq);
        u32x4 pw; pw.x = wa.x; pw.y = wa.y; pw.z = wb.x; pw.w = wb.y;
        const bf16x8 pf = __builtin_bit_cast(bf16x8, pw);
        LAS unsigned char* va = lds + LDS_VT + (32 * js + 4 * fq + (fr >> 2)) * TS + (fr & 3) * 8;
        LAS unsigned char* vb = va + 16 * TS;
#pragma unroll
        for (int dt = 0; dt < 4; ++dt) {
            const s16x4 xa = tr_read(va + dt * 32), xb = tr_read(vb + dt * 32);
            const bf16x8 xf = __builtin_shufflevector(xa, xb, 0, 1, 2, 3, 4, 5, 6, 7);
            O[dt] = MFMA16(xf, pf, O[dt]);
        }
    }
    const float bs = a.in[I_BSP][(jl * 8 + g) * 128 + i];
    const bf16* up = Ub + (r0 + i) * 512 + g * 64 + 4 * fq; bf16* cp = CAT + (r0 + i) * DM + 512 + g * 64 + 4 * fq;
#pragma unroll
    for (int dt = 0; dt < 4; ++dt) {
        const u32x2 uu = *(const u32x2*)(up + 16 * dt);
        u32x2 o; o.x = pk2(bflo(uu.x) * (O[dt][0] + bs), bfhi(uu.x) * (O[dt][1] + bs)); o.y = pk2(bflo(uu.y) * (O[dt][2] + bs), bfhi(uu.y) * (O[dt][3] + bs));
        *(u32x2*)(cp + 16 * dt) = o;
    }
}

__device__ __forceinline__ void sample_unit(const Args& a, LAS unsigned char* lds, int n, int jl, int tid, int wid, int lane) {
    unsigned char* ws = a.ws;
    const bf16* Qb = (const bf16*)(ws + WS_Q); const bf16* Kb = (const bf16*)(ws + WS_K); const bf16* Vb = (const bf16*)(ws + WS_V);
    const bf16* VBb = (const bf16*)(ws + WS_VB); const bf16* Ub = (const bf16*)(ws + WS_U); bf16* CAT = (bf16*)(ws + WS_CAT);
    const size_t row = (size_t)MP + n; const int h = wid;
    LAS float* qs = (LAS float*)(lds + wid * 256);
    const float qd = bflo((unsigned)Qb[row * 512 + h * 64 + lane]), kd = bflo((unsigned)Kb[row * 512 + h * 64 + lane]), vd = bflo((unsigned)Vb[row * 512 + h * 64 + lane]);
    qs[lane] = qd;
    const float s_new = wave_sum(qd * kd) * 0.125f;
    const float* ck = a.in[I_CK] + ((size_t)(jl * MS + n) * 2048) * 512 + h * 64;
    const float* cv = a.in[I_CV] + ((size_t)(jl * MS + n) * 2048) * 512 + h * 64;
    float ob[3], ls[3];
#pragma unroll
    for (int br = 0; br < 3; ++br) {
        const int dsh = 2 * br;
        float sc[2];
#pragma unroll
        for (int p = 0; p < 2; ++p) {
            const int i = lane + 64 * p + 1; const float* kr = ck + (size_t)(2048 - (i << dsh)) * 512;
            float s = 0.f;
#pragma unroll
            for (int c = 0; c < 16; ++c) { const f32x4 kv = *(const f32x4*)(kr + 4 * c); const f32x4 qv = *(const LAS f32x4*)(qs + 4 * c); s += (kv.x * qv.x + kv.y * qv.y) + (kv.z * qv.z + kv.w * qv.w); }
            sc[p] = s * 0.125f;
        }
        const float m = fmaxf(wave_max(fmaxf(sc[0], sc[1])), s_new);
        const float p0 = __expf(sc[0] - m), p1 = __expf(sc[1] - m), pn = __expf(s_new - m);
        const float den = wave_sum(p0 + p1) + pn;
        float o = pn * vd;
        for (int e = 0; e < 128; ++e) {
            const float pe = __shfl((e < 64) ? p0 : p1, e & 63);
            o += pe * cv[(size_t)(2048 - ((e + 1) << dsh)) * 512 + lane];
        }
        ob[br] = o / den; ls[br] = m + __logf(den);
    }
    const float m = fmaxf(ls[0], fmaxf(ls[1], ls[2])); const float e0 = __expf(ls[0] - m), e1 = __expf(ls[1] - m), e2 = __expf(ls[2] - m);
    const float att = (e0 * ob[0] + e1 * ob[1] + e2 * ob[2]) / (e0 + e1 + e2);
    CAT[row * DM + h * 64 + lane] = (bf16)f2bf(att);
    {
        const int c = tid, g = c >> 6;
        const float w00 = a.in[I_WSP][(size_t)(jl * 8 + g) * 128 * 128], b0 = a.in[I_BSP][(jl * 8 + g) * 128];
        const float u = bflo((unsigned)Ub[row * 512 + c]), vb = bflo((unsigned)VBb[row * 512 + c]);
        CAT[row * DM + 512 + c] = (bf16)f2bf(u * (w00 * vb + b0));
    }
}

__device__ __forceinline__ void conv_phase(const Args& a, LAS unsigned char* lds, int jl, int tid, int wid, int lane) {
    unsigned char* ws = a.ws;
    const bf16* X = (const bf16*)(ws + WS_X); bf16* Y = (bf16*)(ws + WS_Y); const float* ZS = (const float*)(ws + WS_ZS);
    const int c0 = 2 * tid;
    float w0[31], w1[31];
#pragma unroll
    for (int w = 0; w < 31; ++w) { const float2 t = *(const float2*)(a.in[I_WDW] + (size_t)(jl * 31 + w) * DM + c0); w0[w] = t.x; w1[w] = t.y; }
    const float2 bd = *(const float2*)(a.in[I_BDW] + jl * DM + c0), gg = *(const float2*)(a.in[I_CG] + jl * DM + c0), be = *(const float2*)(a.in[I_CB] + jl * DM + c0);
    LAS float* red = (LAS float*)lds;
    LAS float* tot = (LAS float*)(lds + 1024);
    for (int unit = blockIdx.x; unit < 1024 + MS; unit += gridDim.x) {
        if (unit < 1024) {
            const int b = unit >> 7, t0 = (unit & 127) * 16; const bool lastu = (unit & 127) == 127;
            float a0[16], a1[16];
#pragma unroll
            for (int tt = 0; tt < 16; ++tt) { a0[tt] = bd.x; a1[tt] = bd.y; }
#pragma unroll
            for (int r = 0; r < 46; ++r) {
                const int t = t0 - 30 + r; float x0 = 0.f, x1 = 0.f;
                if (t >= 0) { const unsigned u = *(const unsigned*)(X + ((size_t)b * SEQ + t) * DM + c0); x0 = bflo(u); x1 = bfhi(u); }
#pragma unroll
                for (int tt = 0; tt < 16; ++tt) { const int w = r - tt; if (w >= 0 && w <= 30) { a0[tt] += x0 * w0[w]; a1[tt] += x1 * w1[w]; } }
                if (r >= 16 && lastu) { float2 o; o.x = x0; o.y = x1; *(float2*)(a.out + O_CCP + ((size_t)(jl * NB + b) * 30 + (r - 16)) * DM + c0) = o; }
            }
#pragma unroll
            for (int tt = 0; tt < 16; ++tt) {
                const float s = wave_sum(a0[tt] + a1[tt]), q = wave_sum(a0[tt] * a0[tt] + a1[tt] * a1[tt]);
                if (lane == 0) { red[wid * 32 + tt] = s; red[wid * 32 + 16 + tt] = q; }
            }
            __syncthreads();
            if (tid < 32) { float s = 0.f;
#pragma unroll
                for (int w = 0; w < 8; ++w) s += red[w * 32 + tid];
                tot[tid] = s; }
            __syncthreads();
#pragma unroll
            for (int tt = 0; tt < 16; ++tt) {
                const float mean = tot[tt] * (1.f / DM), var = fmaxf(tot[16 + tt] * (1.f / DM) - mean * mean, 0.f), rstd = rsqrtf(var + EPS);
                const float y0 = (a0[tt] - mean) * rstd * gg.x + be.x, y1 = (a1[tt] - mean) * rstd * gg.y + be.y;
                const float z0 = y0 / (1.f + __expf(-y0)), z1 = y1 / (1.f + __expf(-y1));
                *(unsigned*)(Y + ((size_t)b * SEQ + t0 + tt) * DM + c0) = pk2(z0, z1);
            }
            __syncthreads();
        } else {
            const int n = unit - 1024;
            const int np = 256 * (c0 >> 7) + (c0 & 127);
            const float2 av = *(const float2*)(ZS + (size_t)n * 2048 + np), gv = *(const float2*)(ZS + (size_t)n * 2048 + np + 128);
            const float xn0 = av.x / (1.f + __expf(-gv.x)), xn1 = av.y / (1.f + __expf(-gv.y));
            float s0 = bd.x + xn0 * w0[30], s1 = bd.y + xn1 * w1[30];
            const float* st = a.in[I_CST] + ((size_t)(jl * MS + n) * 30) * DM + c0;
            float* oc = a.out + O_CCS + ((size_t)(jl * MS + n) * 30) * DM + c0;
#pragma unroll
            for (int w = 0; w < 30; ++w) { const float2 sv = *(const float2*)(st + (size_t)w * DM); s0 += sv.x * w0[w]; s1 += sv.y * w1[w]; if (w >= 1) *(float2*)(oc + (size_t)(w - 1) * DM) = sv; }
            { float2 o; o.x = xn0; o.y = xn1; *(float2*)(oc + (size_t)29 * DM) = o; }
            const float s = wave_sum(s0 + s1), q = wave_sum(s0 * s0 + s1 * s1);
            if (lane == 0) { red[wid * 32] = s; red[wid * 32 + 16] = q; }
            __syncthreads();
            if (tid < 32) { float t = 0.f;
#pragma unroll
                for (int w = 0; w < 8; ++w) t += red[w * 32 + tid];
                tot[tid] = t; }
            __syncthreads();
            const float mean = tot[0] * (1.f / DM), var = fmaxf(tot[16] * (1.f / DM) - mean * mean, 0.f), rstd = rsqrtf(var + EPS);
            const float y0 = (s0 - mean) * rstd * gg.x + be.x, y1 = (s1 - mean) * rstd * gg.y + be.y;
            *(unsigned*)(Y + ((size_t)MP + n) * DM + c0) = pk2(y0 / (1.f + __expf(-y0)), y1 / (1.f + __expf(-y1)));
            __syncthreads();
        }
    }
}

template <class F> __device__ __forceinline__ void skinny_gemm(LAS unsigned char* lds, const bf16* A, const bf16* Bt, int N, int K, int tid, int wid, int lane, F f) {
    const int fr = lane & 15, fq = lane >> 4; LAS float* red = (LAS float*)lds;
    const int ks = K >> 3;
    for (int cgp = blockIdx.x; cgp < (N >> 4); cgp += gridDim.x) {
        f32x4 acc0 = {0.f, 0.f, 0.f, 0.f}, acc1 = {0.f, 0.f, 0.f, 0.f};
        const bf16* a0p = A + (size_t)fr * K + wid * ks + fq * 8; const bf16* a1p = a0p + (size_t)16 * K; const bf16* bp = Bt + (size_t)(cgp * 16 + fr) * K + wid * ks + fq * 8;
        for (int kk = 0; kk < ks; kk += 32) {
            const bf16x8 x = *(const bf16x8*)(bp + kk), y0 = *(const bf16x8*)(a0p + kk), y1 = *(const bf16x8*)(a1p + kk);
            acc0 = MFMA16(x, y0, acc0); acc1 = MFMA16(x, y1, acc1);
        }
#pragma unroll
        for (int v = 0; v < 4; ++v) { red[(wid * 32 + fr) * 16 + 4 * fq + v] = acc0[v]; red[(wid * 32 + 16 + fr) * 16 + 4 * fq + v] = acc1[v]; }
        __syncthreads();
        { const int r = tid >> 4, c = tid & 15; float s = 0.f;
#pragma unroll
          for (int w = 0; w < 8; ++w) s += red[(w * 32 + r) * 16 + c];
          f(r, cgp * 16 + c, s); }
        __syncthreads();
    }
}
#ifndef MK_MULTI
#define MK_MULTI 1
#endif
constexpr int N_PHASES = 32;
#ifndef PH_MASK
#define PH_MASK 0xffff
#endif
#define PHON(k) ((PH_MASK >> (k)) & 1)
__global__ void __launch_bounds__(512, 2) fwd_kernel(Args a_unused) {
    extern __shared__ __attribute__((aligned(16))) unsigned char lds_raw[];
    const Args* ap0 = (const Args*)__builtin_amdgcn_kernarg_segment_ptr();
    LAS unsigned char* lds = (LAS unsigned char*)lds_raw;
    cg::grid_group grid = cg::this_grid();
    const int tid0 = threadIdx.x;
    const int ph_lo = ap0->ph_lo, ph_hi = ap0->ph_hi;
    for (int ph = ph_lo; ph < ph_hi; ++ph) {
        int tid = tid0; asm volatile("" : "+v"(tid));
        const int wid = __builtin_amdgcn_readfirstlane(tid >> 6), lane = tid & 63;
        const int half = ph >= 16 ? 1 : 0, kind = ph - 16 * half, L = 2 * half + (kind >= 9 ? 1 : 0), jl = half;
        const bool is_gemm = (kind == 1 || kind == 5 || kind == 7 || kind == 8 || kind == 10 || kind == 12 || kind == 14 || kind == 15);
        if (is_gemm) {
            const Args* ap = ap0; asm volatile("" : "+s"(ap));
            unsigned char* ws = ap->ws; float* out = ap->out;
            int gmode = -1; const bf16* gA = nullptr; const bf16* gB = nullptr; int gN = 0, gK = 0; bf16* gO = nullptr; int gld = 0;
            if (kind == 1 && PHON(1)) { gmode = 0; gA = (const bf16*)(ws + WS_N); gB = (const bf16*)(ws + WS_WIN) + (size_t)jl * DM * ZW; gN = ZW; gK = DM; gO = (bf16*)(ws + WS_Z); gld = ZW; }
            else if ((kind == 7 || kind == 14) && PHON(7)) { gmode = 1; gA = (const bf16*)(ws + WS_N); gB = (const bf16*)(ws + WS_WUP) + (size_t)L * DM * FF; gN = FF; gK = DM; gO = (bf16*)(ws + WS_HID); gld = FF; }
            else if (kind == 10 && PHON(10)) { gmode = 2; gA = (const bf16*)(ws + WS_N); gB = (const bf16*)(ws + WS_WCI) + (size_t)jl * DM * 2048; gN = 2048; gK = DM; gO = (bf16*)(ws + WS_X); gld = DM; }
            else if (kind == 5 && PHON(5)) { gmode = 3; gA = (const bf16*)(ws + WS_CAT); gB = (const bf16*)(ws + WS_WOUT) + (size_t)jl * DM * DM; gN = DM; gK = DM; gld = DM; }
            else if (kind == 12 && PHON(5)) { gmode = 3; gA = (const bf16*)(ws + WS_Y); gB = (const bf16*)(ws + WS_WCO) + (size_t)jl * DM * DM; gN = DM; gK = DM; gld = DM; }
            else if ((kind == 8 || kind == 15) && PHON(5)) { gmode = 3; gA = (const bf16*)(ws + WS_HID); gB = (const bf16*)(ws + WS_WDN) + (size_t)L * DM * FF; gN = DM; gK = FF; gld = DM; }
            if (gmode >= 0) {
                const float* bp = (ph == 5) ? ap->in[I_XP] : out + O_YP; const float* bs = (ph == 5) ? ap->in[I_XS] : out + O_YS;
                pg8::EpiAll E{gmode, gO, gld, bp, out + O_YP};
                pg8::Gemm g{gA, gB, MP, gN, gK}; pg8::StaticOrder S; S.init(MP, gN, (int)gridDim.x, (int)blockIdx.x);
                pg8::gemm_phase<pg8::EpiAll, pg8::StaticOrder, true, true>(lds, g, S, E, tid);
                float* os = out + O_YS; float* zs = (float*)(ws + WS_ZS);
                skinny_gemm(lds, gA + (size_t)MP * gK, gB, gN, gK, tid, wid, lane, [=](int r, int c, float v) {
                    if (gmode == 3) os[r * DM + c] = bs[r * DM + c] + v;
                    else if (gmode == 2) zs[r * 2048 + c] = v;
                    else { const float t = fmaxf(v, 0.f); gO[(size_t)(MP + r) * gld + c] = (bf16)f2bf(gmode == 1 ? t * t : v); }
                });
            }
        } else {
            const Args* ap = ap0; asm volatile("" : "+s"(ap));
            const Args& a = *ap;
            switch (kind) {
            case 0: case 6: case 9: case 13: if (PHON(0)) {
                if (ph == 0) prologue(a, lds, tid, wid, lane);
                const bool mix = (kind == 0 || kind == 9);
                const float* hp = (ph == 0) ? a.in[I_XP] : a.out + O_YP; const float* hs = (ph == 0) ? a.in[I_XS] : a.out + O_YS;
                norm_phase(hp, hs, a.in[mix ? I_GMIX : I_GFFN] + L * DM, (bf16*)(a.ws + WS_N), wid, lane);
            } break;
            case 2: if (PHON(2)) post_phase(a, jl, wid, lane); break;
            case 3: if (PHON(3)) {
                for (int u = blockIdx.x; u < 3072 + 1024 + MS; u += gridDim.x) {
                    __syncthreads();
                    if (u < 3072) attn_unit(a, lds, u, tid, wid, lane);
                    else if (u < 4096) spatial_unit(a, lds, u - 3072, jl, tid, wid, lane);
                    else sample_unit(a, lds, u - 4096, jl, tid, wid, lane);
                }
            } break;
            case 4: if (PHON(4)) combine_phase(a, wid, lane); break;
            case 11: if (PHON(11)) conv_phase(a, lds, jl, tid, wid, lane); break;
            default: break;
            }
        }
        if (ph + 1 < ph_hi) grid.sync();
    }
}

extern "C" void kernel_launch(void* const* d_in, const int* in_sizes, int n_in, void* d_out, int out_size, void* d_ws, size_t ws_size, hipStream_t stream) {
    static int grid = 0;
    if (grid == 0) {
        if (n_in != 23 || (size_t)out_size != O_END || ws_size < WS_END) { fprintf(stderr, "kernel_launch: unexpected sizes n_in %d out %d ws %zu\n", n_in, out_size, ws_size); grid = -1; return; }
        int dev = 0, cus = 0, per_cu = 0;
        (void)hipGetDevice(&dev); (void)hipDeviceGetAttribute(&cus, hipDeviceAttributeMultiprocessorCount, dev);
        if (hipFuncSetAttribute((const void*)fwd_kernel, hipFuncAttributeMaxDynamicSharedMemorySize, LDS_BYTES) != hipSuccess) { fprintf(stderr, "kernel_launch: hipFuncSetAttribute failed\n"); grid = -1; return; }
        if (hipOccupancyMaxActiveBlocksPerMultiprocessor(&per_cu, (const void*)fwd_kernel, 512, LDS_BYTES) != hipSuccess || per_cu < 1) { fprintf(stderr, "kernel_launch: occupancy query failed (%d)\n", per_cu); (void)hipGetLastError(); per_cu = 1; }
        grid = cus * per_cu;
        if (grid <= 0) grid = 256;
    }
    if (grid < 0) return;
    Args a{};
    for (int i = 0; i < 23; ++i) a.in[i] = (const float*)d_in[i];
    a.out = (float*)d_out; a.ws = (unsigned char*)d_ws;
#if MK_MULTI
    for (int ph = 0; ph < N_PHASES; ++ph) { a.ph_lo = ph; a.ph_hi = ph + 1; hipLaunchKernelGGL(fwd_kernel, dim3(grid), dim3(512), LDS_BYTES, stream, a); }
#else
    a.ph_lo = 0; a.ph_hi = N_PHASES;
    void* args[] = {&a};
    hipError_t e = hipLaunchCooperativeKernel((const void*)fwd_kernel, dim3(grid), dim3(512), args, LDS_BYTES, stream);
    if (e != hipSuccess) fprintf(stderr, "cooperative launch failed: %s (grid %d)\n", hipGetErrorString(e), grid);
#endif
}
```

```cpp
#include <hip/hip_runtime.h>
#include <hip/hip_cooperative_groups.h>
#include <cstdio>
#include <cstdint>
#include <cmath>
namespace cg = cooperative_groups;
namespace pg8 {
#define PG8_LAS __attribute__((address_space(3)))
typedef unsigned short bf16_t;
typedef short bf16x8 __attribute__((ext_vector_type(8)));
typedef float f32x4 __attribute__((ext_vector_type(4)));
typedef unsigned u32x4 __attribute__((ext_vector_type(4)));
constexpr int BM = 256, BK = 64, HALF = 128, HTB = HALF * BK * 2  , STAGE_BYTES = 8 * HTB, NXCD = 8, WGM = 4;

__host__ __device__ __forceinline__ int lds_byte(int r, int c) { const int st = (r >> 4) * 2 + (c >> 5), rr = r & 15, cc = c & 31, ob = rr * 64 + cc * 2; return st * 1024 + (ob ^ (((ob >> 9) & 1) << 5)); }
__host__ __device__ __forceinline__ void stage_rc(int b, int& R, int& C) { const int st = b / 1024, sb = b % 1024, swz = sb ^ (((sb >> 9) & 1) << 5); R = (st >> 1) * 16 + swz / 64; C = (st & 1) * 32 + (swz % 64) / 2; }
__host__ __device__ __forceinline__ int perm32(int rho) { const int n = rho >> 4, i = rho & 15; return 8 * (i >> 2) + 4 * n + (i & 3); }

struct Unit { int pm, pn; };
struct Gemm { const bf16_t* A; const bf16_t* Bt; int M, N, K; };

struct StaticOrder {
    int nM, nN, nwg, G, c;
    __host__ __device__ void init(int M, int N, int G_, int c_) { nM = M / BM; nN = N / BM; nwg = nM * nN; G = G_; c = c_; }
    __host__ __device__ bool next(int i, Unit& u) const {
        const long L = (long)i * G + c; if (L >= nwg) return false;
        int wgid = (int)L; { const int q = nwg / NXCD, r = nwg % NXCD, xcd = wgid % NXCD, off = wgid / NXCD; wgid = (xcd < r ? xcd * (q + 1) : r * (q + 1) + (xcd - r) * q) + off; }
        const int nig = WGM * nN, gid = wgid / nig, fm = gid * WGM, gsz = (nM - fm) < WGM ? (nM - fm) : WGM;
        u.pm = fm + ((wgid % nig) % gsz); u.pn = (wgid % nig) / gsz; return true;
    }
    __device__ __forceinline__ void a_ready(const Unit&) const {}
    __device__ __forceinline__ void done(const Unit&) const {}
};
typedef float f32x2 __attribute__((ext_vector_type(2)));
typedef __bf16 bf16x2v __attribute__((ext_vector_type(2)));
__device__ __forceinline__ unsigned pkbf(float lo, float hi) { f32x2 v = {lo, hi}; bf16x2v b = __builtin_convertvector(v, bf16x2v); return __builtin_bit_cast(unsigned, b); }
template <class Epi, class Sched, bool ALIGN_EPI = false, bool SP2 = false>
__device__ __forceinline__ void gemm_phase(PG8_LAS unsigned char* lds, const Gemm g, const Sched& S, const Epi& E, const int tid_in) {
    const int tid = tid_in, wid = __builtin_amdgcn_readfirstlane(tid >> 6), lane = tid & 63, wr = wid >> 2, wc = wid & 3, fr = lane & 15, fq = lane >> 4;
    const int K = g.K, nt = K / BK;
    unsigned voffA[2], voffB[2];
#pragma unroll
    for (int i = 0; i < 2; ++i) { int R, C; stage_rc(tid * 16 + i * 8192, R, C); const int Rb = Epi::PERM ? ((R & ~31) + perm32(R & 31)) : R;
        voffA[i] = (unsigned)(R * K + C) * 2u; voffB[i] = (unsigned)(Rb * K + C) * 2u; }
    const size_t kstep = (size_t)(BK * 2);
    const size_t hstep = (size_t)HALF * K * 2;
    const size_t tstep = 2 * hstep;
    const unsigned ldsw = (unsigned)wid * 1024u;
    const int aoff = lds_byte(wr * 64 + fr, fq * 8), boff = lds_byte(wc * 32 + fr, fq * 8);
#define PG8_SA(b, h) (((b) * 2 + (h)) * HTB)
#define PG8_SB(b, h) ((4 + (b) * 2 + (h)) * HTB)
#define PG8_STAGE(bufoff, gbase, voff) do { _Pragma("unroll") for (int _i = 0; _i < 2; ++_i) \
        __builtin_amdgcn_global_load_lds((const unsigned*)((const char*)(gbase) + (voff)[_i]), (PG8_LAS unsigned*)(lds + (bufoff) + ldsw + _i * 8192), 16, 0, 0); } while (0)
#define PG8_LDA(dst, b, h) do { _Pragma("unroll") for (int m = 0; m < 4; ++m) _Pragma("unroll") for (int k = 0; k < 2; ++k) dst[m][k] = *(const PG8_LAS bf16x8*)(lds + PG8_SA(b, h) + aoff + m * 2048 + k * 1024); } while (0)
#define PG8_LDB(dst, b, h) do { _Pragma("unroll") for (int n = 0; n < 2; ++n) _Pragma("unroll") for (int k = 0; k < 2; ++k) dst[n][k] = *(const PG8_LAS bf16x8*)(lds + PG8_SB(b, h) + boff + n * 2048 + k * 1024); } while (0)
#define PG8_MMA(ai, bj, At, Bt) do { __builtin_amdgcn_s_setprio(1); _Pragma("unroll") for (int m = 0; m < 4; ++m) _Pragma("unroll") for (int n = 0; n < 2; ++n) _Pragma("unroll") for (int k = 0; k < 2; ++k) \
        acc[ai][bj][m][n] = __builtin_amdgcn_mfma_f32_16x16x32_bf16(Bt[n][k], At[m][k], acc[ai][bj][m][n], 0, 0, 0); __builtin_amdgcn_s_setprio(0); } while (0)
#define PG8_WAIT_V(n) asm volatile("s_waitcnt vmcnt(" #n ")" ::: "memory")
#define PG8_WAIT_L(n) asm volatile("s_waitcnt lgkmcnt(" #n ")" ::: "memory")
#define PG8_BAR __builtin_amdgcn_s_barrier()
#define PG8_SCHED __builtin_amdgcn_sched_barrier(0)
    Unit cur, nxt; int ui = 0;
    if (!S.next(0, cur)) return;
    f32x4 acc[2][2][4][2];
#pragma unroll
    for (int a = 0; a < 2; ++a)
#pragma unroll
        for (int b = 0; b < 2; ++b)
#pragma unroll
            for (int m = 0; m < 4; ++m)
#pragma unroll
                for (int n = 0; n < 2; ++n) acc[a][b][m][n] = (f32x4){0.f, 0.f, 0.f, 0.f};
    bf16x8 At[4][2], B0[2][2], B1[2][2];
    const char* cA = (const char*)g.A + (size_t)cur.pm * tstep; const char* cB = (const char*)g.Bt + (size_t)cur.pn * tstep;
    S.a_ready(cur);
    if constexpr (SP2) {
        PG8_STAGE(PG8_SB(0, 0), cB, voffB); PG8_STAGE(PG8_SB(0, 1), cB + hstep, voffB); PG8_STAGE(PG8_SA(0, 0), cA, voffA); PG8_STAGE(PG8_SA(0, 1), cA + hstep, voffA);
        if (wr == 1) PG8_BAR;
        PG8_WAIT_V(2); PG8_BAR;
        PG8_STAGE(PG8_SB(1, 0), cB + kstep, voffB); PG8_STAGE(PG8_SA(1, 0), cA + kstep, voffA); PG8_STAGE(PG8_SB(1, 1), cB + hstep + kstep, voffB);
        PG8_WAIT_V(6); PG8_BAR;
    } else {
        PG8_STAGE(PG8_SB(0, 0), cB, voffB); PG8_STAGE(PG8_SA(0, 0), cA, voffA); PG8_STAGE(PG8_SB(0, 1), cB + hstep, voffB); PG8_STAGE(PG8_SA(0, 1), cA + hstep, voffA);
        if (wr == 1) PG8_BAR;
        PG8_WAIT_V(4); PG8_BAR;
        PG8_STAGE(PG8_SB(1, 0), cB + kstep, voffB); PG8_STAGE(PG8_SA(1, 0), cA + kstep, voffA); PG8_STAGE(PG8_SB(1, 1), cB + hstep + kstep, voffB);
        PG8_WAIT_V(6); PG8_BAR;
    }
    for (;;) {
        const bool has_next = S.next(ui + 1, nxt);
        const char* nA = has_next ? (const char*)g.A + (size_t)nxt.pm * tstep : cA; const char* nB = has_next ? (const char*)g.Bt + (size_t)nxt.pn * tstep : cB;
        for (int t = 0; t < nt; t += 2) {
            const bool last = (t == nt - 2);
            const char* a1 = cA + (size_t)(t + 1) * kstep;
            const char* a2 = last ? nA : cA + (size_t)(t + 2) * kstep; const char* b2 = last ? nB : cB + (size_t)(t + 2) * kstep;
            const char* a3 = a2 + kstep; const char* b3 = b2 + kstep;
            if (last && has_next) S.a_ready(nxt);
            if constexpr (SP2) {
            PG8_LDB(B0, 0, 0); PG8_LDB(B1, 0, 1); PG8_SCHED; PG8_LDA(At, 0, 0); PG8_STAGE(PG8_SA(1, 1), a1 + hstep, voffA);
            PG8_WAIT_V(8); PG8_WAIT_L(0); PG8_BAR; PG8_MMA(0, 0, At, B0); PG8_MMA(0, 1, At, B1); PG8_BAR; PG8_SCHED;
            PG8_LDA(At, 0, 1); PG8_STAGE(PG8_SB(0, 0), b2, voffB); PG8_STAGE(PG8_SB(0, 1), b2 + hstep, voffB); PG8_STAGE(PG8_SA(0, 0), a2, voffA);
            PG8_WAIT_V(8); PG8_WAIT_L(0); PG8_BAR; PG8_MMA(1, 0, At, B0); PG8_MMA(1, 1, At, B1); PG8_BAR; PG8_SCHED;
            PG8_LDB(B0, 1, 0); PG8_LDB(B1, 1, 1); PG8_SCHED; PG8_LDA(At, 1, 0); PG8_STAGE(PG8_SA(0, 1), a2 + hstep, voffA);
            PG8_WAIT_V(8); PG8_WAIT_L(0); PG8_BAR; PG8_MMA(0, 0, At, B0); PG8_MMA(0, 1, At, B1); PG8_BAR; PG8_SCHED;
            PG8_LDA(At, 1, 1); PG8_STAGE(PG8_SB(1, 0), b3, voffB); PG8_STAGE(PG8_SB(1, 1), b3 + hstep, voffB); PG8_STAGE(PG8_SA(1, 0), a3, voffA);
            PG8_WAIT_V(8); PG8_WAIT_L(0); PG8_BAR; PG8_MMA(1, 0, At, B0); PG8_MMA(1, 1, At, B1); PG8_BAR; PG8_SCHED;
            } else {
            PG8_LDB(B0, 0, 0); PG8_SCHED; PG8_LDA(At, 0, 0); PG8_STAGE(PG8_SA(1, 1), a1 + hstep, voffA);
            PG8_WAIT_L(8); PG8_BAR; PG8_WAIT_L(0); PG8_MMA(0, 0, At, B0); PG8_BAR; PG8_SCHED;
            PG8_LDB(B1, 0, 1); PG8_STAGE(PG8_SB(0, 0), b2, voffB);
            PG8_BAR; PG8_WAIT_L(0); PG8_MMA(0, 1, At, B1); PG8_BAR;
            PG8_LDA(At, 0, 1); PG8_STAGE(PG8_SA(0, 0), a2, voffA);
            PG8_BAR; PG8_WAIT_L(0); PG8_MMA(1, 0, At, B0); PG8_BAR; PG8_SCHED;
            PG8_STAGE(PG8_SB(0, 1), b2 + hstep, voffB);
            PG8_WAIT_V(6); PG8_BAR; PG8_MMA(1, 1, At, B1); PG8_BAR;
            PG8_LDB(B0, 1, 0); PG8_SCHED; PG8_LDA(At, 1, 0); PG8_STAGE(PG8_SA(0, 1), a2 + hstep, voffA);
            PG8_WAIT_L(8); PG8_BAR; PG8_WAIT_L(0); PG8_MMA(0, 0, At, B0); PG8_BAR; PG8_SCHED;
            PG8_LDB(B1, 1, 1); PG8_STAGE(PG8_SB(1, 0), b3, voffB);
            PG8_BAR; PG8_WAIT_L(0); PG8_MMA(0, 1, At, B1); PG8_BAR;
            PG8_LDA(At, 1, 1); PG8_STAGE(PG8_SA(1, 0), a3, voffA);
            PG8_BAR; PG8_WAIT_L(0); PG8_MMA(1, 0, At, B0); PG8_BAR; PG8_SCHED;
            PG8_STAGE(PG8_SB(1, 1), b3 + hstep, voffB);
            PG8_WAIT_V(6); PG8_BAR; PG8_MMA(1, 1, At, B1); PG8_BAR;
            }
        }
        if constexpr (ALIGN_EPI) { if (wr == 0) PG8_BAR; }
        if constexpr (!Epi::AFTER_DRAIN) { int fr2 = fr, fq2 = fq; asm volatile("" : "+v"(fr2), "+v"(fq2));   E(acc, cur, wr, wc, fr2, fq2); S.done(cur); }
        if (!has_next) break;
#pragma unroll
        for (int a = 0; a < 2; ++a)
#pragma unroll
            for (int b = 0; b < 2; ++b)
#pragma unroll
                for (int m = 0; m < 4; ++m)
#pragma unroll
                    for (int n = 0; n < 2; ++n) acc[a][b][m][n] = (f32x4){0.f, 0.f, 0.f, 0.f};
        cur = nxt; cA = nA; cB = nB; ++ui;
        if constexpr (ALIGN_EPI) { if (wr == 1) PG8_BAR; }
    }
    PG8_WAIT_V(0);
    if constexpr (!ALIGN_EPI) { if (wr == 0) PG8_BAR; }
    PG8_BAR;
    if constexpr (Epi::AFTER_DRAIN) { E.fused(acc, cur, wr, wc, fr, fq, lds, wid, lane); S.done(cur); }
#undef PG8_SA
#undef PG8_SB
#undef PG8_STAGE
#undef PG8_LDA
#undef PG8_LDB
#undef PG8_MMA
#undef PG8_WAIT_V
#undef PG8_WAIT_L
#undef PG8_BAR
#undef PG8_SCHED
}
}
#define LAS __attribute__((address_space(3)))
typedef unsigned short bf16;
typedef short bf16x8 __attribute__((ext_vector_type(8)));
typedef short s16x4 __attribute__((ext_vector_type(4)));
typedef float f32x4 __attribute__((ext_vector_type(4)));
typedef unsigned u32x4 __attribute__((ext_vector_type(4)));
typedef unsigned u32x2 __attribute__((ext_vector_type(2)));

constexpr int DM = 1024, MP = 16384, MS = 32, MT = MP + MS, MPAD = 16640, SEQ = 2048, NB = 8;
constexpr int ZW = 2560, FF = 4096;
constexpr float EPS = 1e-6f;
constexpr size_t O_YP = 0, O_YS = 16777216, O_AKP = 16809984, O_AVP = 33587200, O_AKS = 50364416, O_AVS = 50397184,
                 O_BVP = 50429952, O_BVS = 51478528, O_CCP = 51511296, O_CCS = 52002816, O_END = 53968896;
constexpr size_t MiB = 1u << 20;
constexpr size_t WS_ROPE = 1 * MiB, WS_WSP = 2 * MiB, WS_ZS = 3 * MiB, WS_RS = 4 * MiB;
constexpr size_t WS_WUP = 8 * MiB, WS_WDN = 40 * MiB, WS_WIN = 72 * MiB, WS_WOUT = 82 * MiB, WS_WCI = 86 * MiB, WS_WCO = 94 * MiB;
constexpr size_t WS_N = 100 * MiB, WS_Z = 134 * MiB, WS_Q = 216 * MiB, WS_K = 233 * MiB, WS_V = 250 * MiB, WS_U = 267 * MiB, WS_VB = 284 * MiB;
constexpr size_t WS_OP = 301 * MiB, WS_LP = 350 * MiB, WS_CAT = 352 * MiB, WS_HID = 386 * MiB, WS_X = 516 * MiB, WS_Y = 550 * MiB, WS_END = 584 * MiB;
constexpr int LDS_BYTES = 163840, LDS_BAR_OFF = 148480;
constexpr size_t WS_BAR = 0;

typedef unsigned long long rs_t;
__device__ __forceinline__ rs_t rs_enc(float s) { return (rs_t)(s * 1048576.f + 0.5f); }
__device__ __forceinline__ float rs_scale(rs_t v) { return rsqrtf((float)v * (1.f / (1048576.f * 1024.f)) + 1e-6f); }
#define GAS __attribute__((address_space(1)))
struct Args { GAS const float* in[23]; GAS float* out; GAS unsigned char* ws; int ph_lo, ph_hi; };
typedef const __attribute__((address_space(4))) Args* ArgsK;
#define AIN(a, i) ((const float*)(a)->in[i])
#define AWS(a) ((unsigned char*)(a)->ws)
#define AOUT(a) ((float*)(a)->out)
enum { I_XP = 0, I_XS, I_CK, I_CV, I_CST, I_GMIX, I_GFFN, I_WUP, I_WDN, I_WIN, I_QG, I_KG, I_VBG, I_VBB, I_WSP, I_BSP, I_WOUT, I_WCI, I_WDW, I_BDW, I_CG, I_CB, I_WCO };

__device__ __forceinline__ int bidx() { int b = (int)blockIdx.x; asm volatile("" : "+s"(b)); return b; }
__device__ __forceinline__ float wave_sum(float v) {
#pragma unroll
    for (int o = 1; o < 64; o <<= 1) v += __shfl_xor(v, o);
    return v;
}
__device__ __forceinline__ float wave_max(float v) {
#pragma unroll
    for (int o = 1; o < 64; o <<= 1) v = fmaxf(v, __shfl_xor(v, o));
    return v;
}
__device__ __forceinline__ float bflo(unsigned u) { return __uint_as_float(u << 16); }
__device__ __forceinline__ float bfhi(unsigned u) { return __uint_as_float(u & 0xffff0000u); }
__device__ __forceinline__ unsigned f2bf(float f) { unsigned u = __float_as_uint(f); return (u + 0x7fffu + ((u >> 16) & 1u)) >> 16; }
__device__ __forceinline__ unsigned pk2(float lo, float hi) { return pg8::pkbf(lo, hi); }
__device__ __forceinline__ float gelu_tanh(float x) {
    const float y = 0.7978845608028654f * (x + 0.044715f * x * x * x);
    const float t = 1.f - 2.f * __builtin_amdgcn_rcpf(__expf(2.f * y) + 1.f);
    return 0.5f * x * (1.f + t);
}

__device__ __forceinline__ void transpose_item(const float* W, int K, int N, bf16* WT, bool glu, const float* gk, int item, int lane) {
    const int nblk = N / 32, i0 = 2 * item, kb = i0 / nblk, nb = i0 % nblk, k0 = 64 * kb, n0 = 32 * nb;
    const int nq = lane & 7, kq = lane >> 3;
    const float* src = W + (size_t)(k0 + 8 * kq) * N + n0 + 4 * nq;
    f32x4 v[2][8];
#pragma unroll
    for (int h2 = 0; h2 < 2; ++h2)
#pragma unroll
        for (int i = 0; i < 8; ++i) v[h2][i] = *(const f32x4*)(src + (size_t)i * N + 32 * h2);
    if (gk) {
        const f32x4 ga = *(const f32x4*)(gk + k0 + 8 * kq), gb = *(const f32x4*)(gk + k0 + 8 * kq + 4);
#pragma unroll
        for (int h2 = 0; h2 < 2; ++h2)
#pragma unroll
            for (int i = 0; i < 4; ++i) { v[h2][i] = v[h2][i] * ga[i]; v[h2][4 + i] = v[h2][4 + i] * gb[i]; }
    }
#pragma unroll
    for (int h2 = 0; h2 < 2; ++h2) {
        const int nn = n0 + 32 * h2;
        const int d0 = glu ? (256 * ((nn & 1023) >> 7) + 128 * (nn >> 10) + (nn & 127)) : nn;
        bf16* dst = WT + (size_t)(d0 + 4 * nq) * K + k0 + 8 * kq;
#pragma unroll
        for (int j = 0; j < 4; ++j) { u32x4 o; o.x = pk2(v[h2][0][j], v[h2][1][j]); o.y = pk2(v[h2][2][j], v[h2][3][j]); o.z = pk2(v[h2][4][j], v[h2][5][j]); o.w = pk2(v[h2][6][j], v[h2][7][j]);
            *(u32x4*)(dst + (size_t)j * K) = o; }
    }
}

__device__ __forceinline__ void convert_set(ArgsK a, int set, int widx, int nw, int lane) {
    unsigned char* ws = AWS(a);
    constexpr int IPL[6] = {16 * 64, 64 * 16, 16 * 40, 16 * 16, 16 * 32, 16 * 16};
    int l0[6], l1[6];
    if (set == 0)      { l0[0] = 0; l1[0] = 0; l0[1] = 0; l1[1] = 0; l0[2] = 0; l1[2] = 1; l0[3] = 0; l1[3] = 0; l0[4] = 0; l1[4] = 0; l0[5] = 0; l1[5] = 0; }
    else if (set == 1) { l0[0] = 0; l1[0] = 2; l0[1] = 0; l1[1] = 2; l0[2] = 1; l1[2] = 2; l0[3] = 0; l1[3] = 1; l0[4] = 0; l1[4] = 1; l0[5] = 0; l1[5] = 1; }
    else               { l0[0] = 2; l1[0] = 4; l0[1] = 2; l1[1] = 4; l0[2] = 0; l1[2] = 0; l0[3] = 1; l1[3] = 2; l0[4] = 1; l1[4] = 2; l0[5] = 1; l1[5] = 2; }
    int cnt[6], total = 0;
#pragma unroll
    for (int m = 0; m < 6; ++m) { cnt[m] = (l1[m] - l0[m]) * IPL[m]; total += cnt[m]; }
    for (int it = widx; it < total; it += nw) {
        int r = it;
        if (r < cnt[0]) { const int l = l0[0] + r / IPL[0]; transpose_item(AIN(a, I_WUP) + (size_t)l * DM * FF, DM, FF, (bf16*)(ws + WS_WUP) + (size_t)l * DM * FF, false, AIN(a, I_GFFN) + l * DM, r % IPL[0], lane); continue; } r -= cnt[0];
        if (r < cnt[1]) { const int l = l0[1] + r / IPL[1]; transpose_item(AIN(a, I_WDN) + (size_t)l * DM * FF, FF, DM, (bf16*)(ws + WS_WDN) + (size_t)l * DM * FF, false, nullptr, r % IPL[1], lane); continue; } r -= cnt[1];
        if (r < cnt[2]) { const int l = l0[2] + r / IPL[2]; transpose_item(AIN(a, I_WIN) + (size_t)l * DM * ZW, DM, ZW, (bf16*)(ws + WS_WIN) + (size_t)l * DM * ZW, false, AIN(a, I_GMIX) + 2 * l * DM, r % IPL[2], lane); continue; } r -= cnt[2];
        if (r < cnt[3]) { const int l = l0[3] + r / IPL[3]; transpose_item(AIN(a, I_WOUT) + (size_t)l * DM * DM, DM, DM, (bf16*)(ws + WS_WOUT) + (size_t)l * DM * DM, false, nullptr, r % IPL[3], lane); continue; } r -= cnt[3];
        if (r < cnt[4]) { const int l = l0[4] + r / IPL[4]; transpose_item(AIN(a, I_WCI) + (size_t)l * DM * 2048, DM, 2048, (bf16*)(ws + WS_WCI) + (size_t)l * DM * 2048, true, AIN(a, I_GMIX) + (2 * l + 1) * DM, r % IPL[4], lane); continue; } r -= cnt[4];
        { const int l = l0[5] + r / IPL[5]; transpose_item(AIN(a, I_WCO) + (size_t)l * DM * DM, DM, DM, (bf16*)(ws + WS_WCO) + (size_t)l * DM * DM, false, nullptr, r % IPL[5], lane); }
    }
}

__device__ __forceinline__ void prologue(ArgsK a, LAS unsigned char* lds, int tid, int wid, int lane) {
    unsigned char* ws = AWS(a);
    const int gw = bidx() * 8 + wid, NGW = gridDim.x * 8;
    convert_set(a, 0, gw, NGW, lane);
    { rs_t* rs = (rs_t*)(ws + WS_RS); const int gt0 = bidx() * 512 + tid, NGT0 = gridDim.x * 512;
      for (int e = gt0; e < 7 * MPAD; e += NGT0) rs[MPAD + e] = 0ull; }
    { bf16* nout = (bf16*)(ws + WS_N); rs_t* rs0 = (rs_t*)(ws + WS_RS);
      for (int row = gw; row < MT; row += NGW) {
        const float* src = (row < MP) ? AIN(a, I_XP) + (size_t)row * DM : AIN(a, I_XS) + (size_t)(row - MP) * DM;
        f32x4 v[4]; float s = 0.f;
#pragma unroll
        for (int j = 0; j < 4; ++j) v[j] = *(const f32x4*)(src + 4 * lane + 256 * j);
        __builtin_amdgcn_sched_barrier(0);
#pragma unroll
        for (int j = 0; j < 4; ++j) s += (v[j].x * v[j].x + v[j].y * v[j].y) + (v[j].z * v[j].z + v[j].w * v[j].w);
        s = wave_sum(s); if (lane == 0) rs0[row] = rs_enc(s);
        bf16* dst = nout + (size_t)row * DM;
#pragma unroll
        for (int j = 0; j < 4; ++j) { u32x2 o; o.x = pk2(v[j].x, v[j].y); o.y = pk2(v[j].z, v[j].w); *(u32x2*)(dst + 4 * lane + 256 * j) = o; }
      } }
    const int gt = bidx() * 512 + tid, NGT = gridDim.x * 512;
    for (int e = gt; e < 2049 * 32; e += NGT) {
        const int pi = e >> 5, i = e & 31; const float pos = (pi < 2048) ? (float)pi : 8192.f;
        const float inv = powf(10000.f, -(float)i / 32.f);
        const float ang = pos * inv;
        double rev = (double)ang * 0.15915494309189533577; rev -= floor(rev);
        const float fr = (float)rev;
        float2 cs; cs.x = __builtin_amdgcn_cosf(fr); cs.y = __builtin_amdgcn_sinf(fr);
        ((float2*)(ws + WS_ROPE))[e] = cs;
    }
    for (int e = gt; e < 2 * 8 * 128 * 128; e += NGT) {
        const int jj = e & 127, i = (e >> 7) & 127; const float w = (jj <= i) ? AIN(a, I_WSP)[e] : 0.f;
        ((bf16*)(ws + WS_WSP))[e] = (bf16)f2bf(w);
    }
}

__device__ __forceinline__ void norm_phase(const float* hp, const float* hs, const float* g, bf16* nout, int wid, int lane) {
    const int gw = bidx() * 8 + wid, NGW = gridDim.x * 8;
    f32x4 gv[4];
#pragma unroll
    for (int j = 0; j < 4; ++j) gv[j] = *(const f32x4*)(g + 4 * lane + 256 * j);
    for (int row = gw; row < MT; row += NGW) {
        const float* src = (row < MP) ? hp + (size_t)row * DM : hs + (size_t)(row - MP) * DM;
        f32x4 v[4]; float s = 0.f;
#pragma unroll
        for (int j = 0; j < 4; ++j) { v[j] = *(const f32x4*)(src + 4 * lane + 256 * j); s += (v[j].x * v[j].x + v[j].y * v[j].y) + (v[j].z * v[j].z + v[j].w * v[j].w); }
        const float r = rsqrtf(wave_sum(s) * (1.f / DM) + EPS);
        bf16* dst = nout + (size_t)row * DM;
#pragma unroll
        for (int j = 0; j < 4; ++j) { u32x2 o; o.x = pk2(v[j].x * r * gv[j].x, v[j].y * r * gv[j].y); o.y = pk2(v[j].z * r * gv[j].z, v[j].w * r * gv[j].w); *(u32x2*)(dst + 4 * lane + 256 * j) = o; }
    }
}

__device__ __forceinline__ void post_phase(ArgsK a, int jl, int wid, int lane) {
    unsigned char* ws = AWS(a);
    const bf16* Z = (const bf16*)(ws + WS_Z);
    bf16* Qb = (bf16*)(ws + WS_Q); bf16* Kb = (bf16*)(ws + WS_K); bf16* Vb = (bf16*)(ws + WS_V); bf16* Ub = (bf16*)(ws + WS_U); bf16* VBb = (bf16*)(ws + WS_VB);
    const float2* rope = (const float2*)(ws + WS_ROPE);
    const int gw = bidx() * 8 + wid, NGW = gridDim.x * 8;
    const int hh = lane >> 3, sub = lane & 7;
    f32x4 gqk[2][2];
#pragma unroll
    for (int which = 0; which < 2; ++which) { const float* g = AIN(a, which ? I_KG : I_QG) + jl * 64; gqk[which][0] = *(const f32x4*)(g + sub * 4); gqk[which][1] = *(const f32x4*)(g + 32 + sub * 4); }
    const float* gvb = AIN(a, I_VBG) + jl * 512 + lane * 8; const float* bvb = AIN(a, I_VBB) + jl * 512 + lane * 8;
    const f32x4 ga = *(const f32x4*)gvb, gb = *(const f32x4*)(gvb + 4), ba = *(const f32x4*)bvb, bb4 = *(const f32x4*)(bvb + 4);
    for (int row = gw; row < MT; row += NGW) {
        const bool samp = row >= MP; const int t = row & (SEQ - 1), bb = row >> 11, ns = row - MP;
        const int pidx = samp ? 2048 : t;
        const bf16* z = Z + (size_t)row * ZW;
        u32x2 zlo[2], zhi[2];
#pragma unroll
        for (int which = 0; which < 2; ++which) { const bf16* src = z + which * 512 + hh * 64 + sub * 4; zlo[which] = *(const u32x2*)src; zhi[which] = *(const u32x2*)(src + 32); }
        const u32x4 zv = *(const u32x4*)(z + 1024 + lane * 8), zb = *(const u32x4*)(z + 2048 + lane * 8);
        float cs[4], sn[4];
#pragma unroll
        for (int i = 0; i < 4; ++i) { const float2 c2 = rope[pidx * 32 + sub * 4 + i]; cs[i] = c2.x; sn[i] = c2.y; }
#pragma unroll
        for (int which = 0; which < 2; ++which) {
            const u32x2 lo = zlo[which], hi = zhi[which];
            float x1[4] = {bflo(lo.x), bfhi(lo.x), bflo(lo.y), bfhi(lo.y)}, x2[4] = {bflo(hi.x), bfhi(hi.x), bflo(hi.y), bfhi(hi.y)};
            float ss = 0.f;
#pragma unroll
            for (int i = 0; i < 4; ++i) ss += x1[i] * x1[i] + x2[i] * x2[i];
            ss += __shfl_xor(ss, 1); ss += __shfl_xor(ss, 2); ss += __shfl_xor(ss, 4);
            const float r = rsqrtf(ss * (1.f / 64.f) + EPS);
            const f32x4 g1 = gqk[which][0], g2 = gqk[which][1];
            f32x4 o1, o2;
#pragma unroll
            for (int i = 0; i < 4; ++i) { const float y1 = x1[i] * r * g1[i], y2 = x2[i] * r * g2[i]; o1[i] = y1 * cs[i] - y2 * sn[i]; o2[i] = y2 * cs[i] + y1 * sn[i]; }
            bf16* dst = (which ? Kb : Qb) + (size_t)row * 512 + hh * 64 + sub * 4;
            u32x2 p1, p2; p1.x = pk2(o1[0], o1[1]); p1.y = pk2(o1[2], o1[3]); p2.x = pk2(o2[0], o2[1]); p2.y = pk2(o2[2], o2[3]);
            *(u32x2*)dst = p1; *(u32x2*)(dst + 32) = p2;
            if (which == 1) {
                float* ok = samp ? AOUT(a) + O_AKS + (size_t)(jl * MS + ns) * 512 : AOUT(a) + O_AKP + ((size_t)jl * MP + row) * 512;
                *(f32x4*)(ok + hh * 64 + sub * 4) = o1; *(f32x4*)(ok + hh * 64 + 32 + sub * 4) = o2;
            }
        }
        {
            const u32x4 vv = zv;
            float* ov = samp ? AOUT(a) + O_AVS + (size_t)(jl * MS + ns) * 512 : AOUT(a) + O_AVP + ((size_t)jl * MP + row) * 512;
            *(f32x4*)(ov + lane * 8) = (f32x4){bflo(vv.x), bfhi(vv.x), bflo(vv.y), bfhi(vv.y)};
            *(f32x4*)(ov + lane * 8 + 4) = (f32x4){bflo(vv.z), bfhi(vv.z), bflo(vv.w), bfhi(vv.w)};
        }
        {
            const u32x4 bv = zb;
            float x[8] = {gelu_tanh(bflo(bv.x)), gelu_tanh(bfhi(bv.x)), gelu_tanh(bflo(bv.y)), gelu_tanh(bfhi(bv.y)), gelu_tanh(bflo(bv.z)), gelu_tanh(bfhi(bv.z)), gelu_tanh(bflo(bv.w)), gelu_tanh(bfhi(bv.w))};
            float s = 0.f;
#pragma unroll
            for (int i = 0; i < 8; ++i) s += x[i];
            const float mean = wave_sum(s) * (1.f / 512.f); float q = 0.f;
#pragma unroll
            for (int i = 0; i < 8; ++i) { x[i] -= mean; q += x[i] * x[i]; }
            const float rstd = rsqrtf(wave_sum(q) * (1.f / 512.f) + EPS);

            f32x4 ya, yb;
#pragma unroll
            for (int i = 0; i < 4; ++i) { ya[i] = x[i] * rstd * ga[i] + ba[i]; yb[i] = x[4 + i] * rstd * gb[i] + bb4[i]; }
            u32x4 o; o.x = pk2(ya[0], ya[1]); o.y = pk2(ya[2], ya[3]); o.z = pk2(yb[0], yb[1]); o.w = pk2(yb[2], yb[3]);
            *(u32x4*)(VBb + (size_t)row * 512 + lane * 8) = o;
            float* ob = nullptr;
            if (samp) ob = AOUT(a) + O_BVS + (size_t)(jl * MS + ns) * 512;
            else if (t >= 1920) ob = AOUT(a) + O_BVP + ((size_t)(jl * NB + bb) * 128 + (t - 1920)) * 512;
            if (ob) { *(f32x4*)(ob + lane * 8) = ya; *(f32x4*)(ob + lane * 8 + 4) = yb; }
        }
    }
}

__device__ __forceinline__ void combine_phase(ArgsK a, int wid, int lane) {
    unsigned char* ws = AWS(a);
    const bf16* OP = (const bf16*)(ws + WS_OP); const float* LP = (const float*)(ws + WS_LP); bf16* CAT = (bf16*)(ws + WS_CAT);
    const int gw = bidx() * 8 + wid, NGW = gridDim.x * 8; const int hh = lane >> 3;
    for (int row = gw; row < MP; row += NGW) {
        const u32x4 p0 = *(const u32x4*)(OP + ((size_t)0 * MPAD + row) * 512 + lane * 8), p1 = *(const u32x4*)(OP + ((size_t)1 * MPAD + row) * 512 + lane * 8), p2 = *(const u32x4*)(OP + ((size_t)2 * MPAD + row) * 512 + lane * 8);
        const float l0 = LP[((size_t)0 * MPAD + row) * 8 + hh], l1 = LP[((size_t)1 * MPAD + row) * 8 + hh], l2 = LP[((size_t)2 * MPAD + row) * 8 + hh];
        __builtin_amdgcn_sched_barrier(0);
        const float m = fmaxf(l0, fmaxf(l1, l2)); float e0 = __expf(l0 - m), e1 = __expf(l1 - m), e2 = __expf(l2 - m); const float inv = __builtin_amdgcn_rcpf(e0 + e1 + e2);
        e0 *= inv; e1 *= inv; e2 *= inv;
        u32x4 o;
#pragma unroll
        for (int i = 0; i < 4; ++i) { const float lo = e0 * bflo(p0[i]) + e1 * bflo(p1[i]) + e2 * bflo(p2[i]), hi = e0 * bfhi(p0[i]) + e1 * bfhi(p1[i]) + e2 * bfhi(p2[i]); o[i] = pk2(lo, hi); }
        *(u32x4*)(CAT + (size_t)row * DM + lane * 8) = o;
    }
}
struct GemmCfg { int mode; const bf16* A; const bf16* B; int N, K; bf16* O; int ld; const float* xin; const float* xins; float* yout; bf16* hb; bool first, last; const rs_t* rs; rs_t* rsn; };
__device__ __forceinline__ bool gemm_cfg(ArgsK ap, int ph, GemmCfg& c) {
    unsigned char* ws = AWS(ap); float* out = AOUT(ap);
    const int half = ph >= 16 ? 1 : 0, kind = ph - 16 * half, L = 2 * half + (kind >= 9 ? 1 : 0), jl = half;
    c.mode = -1; c.O = nullptr; c.ld = DM; c.A = (const bf16*)(ws + WS_N); c.B = nullptr; c.N = DM; c.K = DM;
    if (kind == 1) { c.mode = 0; c.B = (const bf16*)(ws + WS_WIN) + (size_t)jl * DM * ZW; c.N = ZW; c.O = (bf16*)(ws + WS_Z); c.ld = ZW; }
    else if (kind == 7 || kind == 14) { c.mode = 1; c.B = (const bf16*)(ws + WS_WUP) + (size_t)L * DM * FF; c.N = FF; c.O = (bf16*)(ws + WS_HID); c.ld = FF; }
    else if (kind == 10) { c.mode = 2; c.B = (const bf16*)(ws + WS_WCI) + (size_t)jl * DM * 2048; c.N = 2048; c.O = (bf16*)(ws + WS_X); }
    else if (kind == 5) { c.mode = 3; c.A = (const bf16*)(ws + WS_CAT); c.B = (const bf16*)(ws + WS_WOUT) + (size_t)jl * DM * DM; }
    else if (kind == 12) { c.mode = 3; c.A = (const bf16*)(ws + WS_Y); c.B = (const bf16*)(ws + WS_WCO) + (size_t)jl * DM * DM; }
    else if (kind == 8 || kind == 15) { c.mode = 3; c.A = (const bf16*)(ws + WS_HID); c.B = (const bf16*)(ws + WS_WDN) + (size_t)L * DM * FF; c.K = FF; }
    c.xin = AIN(ap, I_XP); c.xins = AIN(ap, I_XS); c.yout = out; c.hb = (bf16*)(ws + WS_N); c.first = (ph == 5); c.last = (ph == 31);
    rs_t* rsb = (rs_t*)(ws + WS_RS);
    c.rs = rsb + (size_t)(2 * L + ((kind == 7 || kind == 14) ? 1 : 0)) * MPAD; c.rsn = nullptr;
    if (c.mode == 3) { if (kind == 5 || kind == 12) c.rsn = rsb + (size_t)(2 * L + 1) * MPAD; else if (L < 3) c.rsn = rsb + (size_t)(2 * L + 2) * MPAD; }
    return c.mode >= 0;
}
struct EpiAll {
    static constexpr bool PERM = true, AFTER_DRAIN = false;
    ArgsK ap0; int ph;
    __device__ __forceinline__ void operator()(const f32x4 (&acc)[2][2][4][2], const pg8::Unit& u, int wr, int wc, int fr, int fq) const {
        using pg8::pkbf; constexpr int BM = pg8::BM, HALF = pg8::HALF; typedef pg8::bf16_t bf16_t;
        ArgsK ap = (ArgsK)ap0; asm volatile("" : "+s"(ap));
        GemmCfg c; gemm_cfg(ap, ph, c);
        const int mode = c.mode; bf16_t* O = c.O; const int ldc = c.ld; const rs_t* rs = c.rs; rs_t* rsn = c.rsn;
        const int row0 = u.pm * BM + wr * 64 + fr;
        if (mode == 3) {
            const int col0 = u.pn * BM + wc * 32 + 8 * fq; const float* xin = c.xin; float* yout = c.yout; bf16_t* hb = c.hb; const bool first = c.first, last = c.last;
#pragma unroll
            for (int ai = 0; ai < 2; ++ai) {
                f32x4 bb[4][2][2];
                if (first) {
#pragma unroll
                    for (int m = 0; m < 4; ++m)
#pragma unroll
                        for (int bj = 0; bj < 2; ++bj) { const size_t off = (size_t)(row0 + ai * HALF + m * 16) * 1024 + col0 + bj * HALF; bb[m][bj][0] = *(const f32x4*)(xin + off); bb[m][bj][1] = *(const f32x4*)(xin + off + 4); }
                } else {
                    u32x4 wv[4][2];
#pragma unroll
                    for (int m = 0; m < 4; ++m)
#pragma unroll
                        for (int bj = 0; bj < 2; ++bj) wv[m][bj] = *(const u32x4*)(hb + (size_t)(row0 + ai * HALF + m * 16) * 1024 + col0 + bj * HALF);
#pragma unroll
                    for (int m = 0; m < 4; ++m)
#pragma unroll
                        for (int bj = 0; bj < 2; ++bj) { const u32x4 w = wv[m][bj];
                            bb[m][bj][0] = (f32x4){__uint_as_float(w.x << 16), __uint_as_float(w.x & 0xffff0000u), __uint_as_float(w.y << 16), __uint_as_float(w.y & 0xffff0000u)};
                            bb[m][bj][1] = (f32x4){__uint_as_float(w.z << 16), __uint_as_float(w.z & 0xffff0000u), __uint_as_float(w.w << 16), __uint_as_float(w.w & 0xffff0000u)}; }
                }
#pragma unroll
                for (int m = 0; m < 4; ++m) { const int row = row0 + ai * HALF + m * 16; const size_t off = (size_t)row * 1024 + col0; float ss = 0.f;
#pragma unroll
                    for (int bj = 0; bj < 2; ++bj) {
                        const f32x4 h0 = bb[m][bj][0] + acc[ai][bj][m][0], h1 = bb[m][bj][1] + acc[ai][bj][m][1];
                        if (last) { *(f32x4*)(yout + off + bj * HALF) = h0; *(f32x4*)(yout + off + bj * HALF + 4) = h1; }
                        else { u32x4 w; w.x = pkbf(h0[0], h0[1]); w.y = pkbf(h0[2], h0[3]); w.z = pkbf(h1[0], h1[1]); w.w = pkbf(h1[2], h1[3]); *(u32x4*)(hb + off + bj * HALF) = w; }
                        ss += (h0[0] * h0[0] + h0[1] * h0[1]) + (h0[2] * h0[2] + h0[3] * h0[3]) + (h1[0] * h1[0] + h1[1] * h1[1]) + (h1[2] * h1[2] + h1[3] * h1[3]); }
                    if (rsn) { ss += __shfl_xor(ss, 16); ss += __shfl_xor(ss, 32); if (fq == 0) atomicAdd(rsn + row, rs_enc(ss)); } }
            }
        } else if (mode == 2) {
            const int col0 = u.pn * HALF + wc * 32 + 8 * fq;
            rs_t rv[2][4];
#pragma unroll
            for (int ai = 0; ai < 2; ++ai)
#pragma unroll
                for (int m = 0; m < 4; ++m) rv[ai][m] = rs[row0 + ai * HALF + m * 16];
            __builtin_amdgcn_sched_barrier(0);
#pragma unroll
            for (int ai = 0; ai < 2; ++ai)
#pragma unroll
                for (int m = 0; m < 4; ++m) { const int row = row0 + ai * HALF + m * 16; bf16_t* rowp = O + (size_t)row * ldc + col0;
                    const float sc = rs_scale(rv[ai][m]);
                    f32x4 x0, x1;
#pragma unroll
                    for (int e = 0; e < 4; ++e) { x0[e] = sc * acc[ai][0][m][0][e] * __builtin_amdgcn_rcpf(1.f + __expf(-sc * acc[ai][1][m][0][e])); x1[e] = sc * acc[ai][0][m][1][e] * __builtin_amdgcn_rcpf(1.f + __expf(-sc * acc[ai][1][m][1][e])); }
                    u32x4 w; w.x = pkbf(x0[0], x0[1]); w.y = pkbf(x0[2], x0[3]); w.z = pkbf(x1[0], x1[1]); w.w = pkbf(x1[2], x1[3]);
                    *(u32x4*)rowp = w; }
        } else {
            const int col0 = u.pn * BM + wc * 32 + 8 * fq;
            rs_t rv[2][4];
#pragma unroll
            for (int ai = 0; ai < 2; ++ai)
#pragma unroll
                for (int m = 0; m < 4; ++m) rv[ai][m] = rs[row0 + ai * HALF + m * 16];
            __builtin_amdgcn_sched_barrier(0);
#pragma unroll
            for (int ai = 0; ai < 2; ++ai)
#pragma unroll
                for (int m = 0; m < 4; ++m) { const int row = row0 + ai * HALF + m * 16; bf16_t* rowp = O + (size_t)row * ldc + col0;
                    const float sc = rs_scale(rv[ai][m]);
#pragma unroll
                    for (int bj = 0; bj < 2; ++bj) { f32x4 v0 = acc[ai][bj][m][0] * sc, v1 = acc[ai][bj][m][1] * sc;
                        if (mode == 1) {
#pragma unroll
                            for (int e = 0; e < 4; ++e) { const float a = fmaxf(v0[e], 0.f), b = fmaxf(v1[e], 0.f); v0[e] = a * a; v1[e] = b * b; } }
                        u32x4 w; w.x = pkbf(v0[0], v0[1]); w.y = pkbf(v0[2], v0[3]); w.z = pkbf(v1[0], v1[1]); w.w = pkbf(v1[2], v1[3]);
                        *(u32x4*)(rowp + bj * HALF) = w; } }
        }
    }
};
#define XB_TMO      128
#define XB_XCNT(j)  (256  + 64 * (j))
#define XB_XSUB(j)  (1280 + 64 * (j))
#define XB_XGEN(j)  (2304 + 64 * (j))
#define XB_TOP      3328
#define XB_TOPGEN   3392
#define XCD_BAR_WORDS 3456
#define XB_SPIN_CAP (1u << 18)

__device__ __forceinline__ unsigned xb_ld(unsigned* p)              { return __hip_atomic_load(p, __ATOMIC_RELAXED, __HIP_MEMORY_SCOPE_AGENT); }
__device__ __forceinline__ unsigned xb_add(unsigned* p, unsigned v) { return __hip_atomic_fetch_add(p, v, __ATOMIC_RELAXED, __HIP_MEMORY_SCOPE_AGENT); }
__device__ __forceinline__ unsigned xb_xcc_id() { return (unsigned)__builtin_amdgcn_s_getreg((3 << 11) | 20) & 0xFu; }
#define XB_SPIN(cond, bar) do { unsigned _sp = 0; while (cond) { __builtin_amdgcn_s_sleep(1); \
    if ((++_sp & 255u) == 0u) { if (xb_ld(&(bar)[XB_TMO])) break; if (_sp > XB_SPIN_CAP) { atomicAdd(&(bar)[XB_TMO], 1u); break; } } } } while (0)

struct XcdBarrier {
    unsigned* bar; unsigned x;
    volatile LAS unsigned* st;
};

__device__ __forceinline__ XcdBarrier xcd_barrier_post(unsigned* bar, volatile LAS unsigned* st) {
    XcdBarrier b; b.bar = bar; b.x = xb_xcc_id(); b.st = st;
    if (threadIdx.x == 0) (void)xb_add(&bar[XB_XCNT(b.x)], 1u);
    return b;
}
__device__ __forceinline__ void xcd_barrier_complete(unsigned* bar, unsigned x, unsigned& nloc, unsigned& nx) {
    const unsigned G = gridDim.x * gridDim.y * gridDim.z;
    unsigned sum, cnt, mine, sp = 0u;
    for (;;) {
        sum = 0u; cnt = 0u; mine = 0u;
#pragma unroll
        for (unsigned j = 0; j < 16; ++j) { const unsigned c = xb_ld(&bar[XB_XCNT(j)]); sum += c; cnt += (c > 0u) ? 1u : 0u; mine = (j == x) ? c : mine; }
        if (sum == G) break;
        __builtin_amdgcn_s_sleep(1);
        if ((++sp & 255u) == 0u) { if (xb_ld(&bar[XB_TMO])) break; if (sp > XB_SPIN_CAP) { atomicAdd(&bar[XB_TMO], 1u); break; } }
    }
    nloc = mine > 0u ? mine : 1u; nx = cnt > 0u ? cnt : 1u;
}

__device__ __forceinline__ void xcd_barrier(const XcdBarrier& b) {
    asm volatile("s_waitcnt vmcnt(0)" ::: "memory");
    __syncthreads();
    if (threadIdx.x == 0) {
        unsigned* bar = b.bar;
        __builtin_amdgcn_s_waitcnt(0);
        unsigned nloc = b.st[0], nx = b.st[1];
        if (nloc == 0u) { xcd_barrier_complete(bar, b.x, nloc, nx); b.st[0] = nloc; b.st[1] = nx; }
        const unsigned old = xb_add(&bar[XB_XSUB(b.x)], 1u);
        const unsigned gen = old / nloc;
        if (old + 1u == (gen + 1u) * nloc) {
            __builtin_amdgcn_fence(__ATOMIC_RELEASE, "agent");
            asm volatile("s_waitcnt vmcnt(0)" ::: "memory");
            const unsigned og = xb_add(&bar[XB_TOP], 1u);
            const unsigned tg = og / nx;
            if (og + 1u == (tg + 1u) * nx) xb_add(&bar[XB_TOPGEN], 1u);
            else XB_SPIN(xb_ld(&bar[XB_TOPGEN]) == tg, bar);
            __builtin_amdgcn_fence(__ATOMIC_ACQUIRE, "agent");
            xb_add(&bar[XB_XGEN(b.x)], 1u);
            asm volatile("s_waitcnt vmcnt(0)" ::: "memory");
        } else {
            XB_SPIN(xb_ld(&bar[XB_XGEN(b.x)]) == gen, bar);
            __builtin_amdgcn_fence(__ATOMIC_ACQUIRE, "agent");
            asm volatile("s_waitcnt vmcnt(0)" ::: "memory");
        }
    }
    __syncthreads();
}
constexpr int TS = 144;
constexpr int LDS_KT = 0, LDS_VT = 256 * TS;
__device__ __forceinline__ s16x4 tr_read(LAS unsigned char* p) { return __builtin_bit_cast(s16x4, __builtin_amdgcn_ds_read_tr16_b64_v4i16((LAS s16x4*)p)); }
#define MFMA16(x, y, c) __builtin_amdgcn_mfma_f32_16x16x32_bf16((x), (y), (c), 0, 0, 0)

struct AttnIdx { int br, b, h, dsh, res, qb; size_t rowb; };
__device__ __forceinline__ AttnIdx attn_decode(int unit) {
    AttnIdx x; x.br = unit >> 10; const int rem = unit & 1023, bh = rem >> 4, idx = rem & 15; x.b = bh >> 3; x.h = bh & 7;
    x.dsh = 2 * x.br; const int nbm = (16 >> x.dsh) - 1; x.res = idx >> (4 - x.dsh); x.qb = idx & nbm; x.rowb = (size_t)x.b * SEQ + x.res; return x;
}
__device__ __forceinline__ void attn_load(ArgsK a, int unit, int tid, u32x4 (&kv)[4], u32x4 (&vv)[4]) {
    const bf16* Kb = (const bf16*)(AWS(a) + WS_K); const bf16* Zv = (const bf16*)(AWS(a) + WS_Z) + 1024;
    const AttnIdx x = attn_decode(unit);
#pragma unroll
    for (int it = 0; it < 4; ++it) {
        const int c = tid + 512 * it, kr = c >> 3, ch = c & 7, s0 = 128 * (x.qb - 1) + kr, s = s0 < 0 ? 0 : s0;
        const size_t row = x.rowb + ((size_t)s << x.dsh); kv[it] = *(const u32x4*)(Kb + row * 512 + x.h * 64 + ch * 8); vv[it] = *(const u32x4*)(Zv + row * ZW + x.h * 64 + ch * 8);
    }
}
__device__ __forceinline__ void attn_stage(LAS unsigned char* lds, int tid, const u32x4 (&kv)[4], const u32x4 (&vv)[4]) {
#pragma unroll
    for (int it = 0; it < 4; ++it) { const int c = tid + 512 * it, kr = c >> 3, ch = c & 7;
        *(LAS u32x4*)(lds + LDS_KT + kr * TS + ch * 16) = kv[it]; *(LAS u32x4*)(lds + LDS_VT + kr * TS + ch * 16) = vv[it]; }
}
__device__ __forceinline__ void attn_loadq(ArgsK a, int unit, int wid, int lane, bf16x8& qf0, bf16x8& qf1) {
    const bf16* Qb = (const bf16*)(AWS(a) + WS_Q); const int fr = lane & 15, fq = lane >> 4;
    const AttnIdx x = attn_decode(unit); const int sq = 128 * x.qb + 16 * wid + fr; const size_t rowq = x.rowb + ((size_t)sq << x.dsh);
    qf0 = *(const bf16x8*)(Qb + rowq * 512 + x.h * 64 + fq * 8); qf1 = *(const bf16x8*)(Qb + rowq * 512 + x.h * 64 + 32 + fq * 8);
}
__device__ __forceinline__ void attn_compute(ArgsK a, LAS unsigned char* lds, int unit, int wid, int lane, const bf16x8 qf0, const bf16x8 qf1) {
    unsigned char* ws = AWS(a);
    bf16* OP = (bf16*)(ws + WS_OP); float* LP = (float*)(ws + WS_LP);
    const int fr = lane & 15, fq = lane >> 4;
    const AttnIdx x = attn_decode(unit); const int br = x.br, h = x.h, qb = x.qb, dsh = x.dsh;
    const int sq = 128 * qb + 16 * wid + fr; const size_t rowq = x.rowb + ((size_t)sq << dsh);
    f32x4 S[10];
#pragma unroll
    for (int kp = 0; kp < 9; ++kp) {
        const int kt = wid + kp; LAS unsigned char* ka = lds + LDS_KT + (16 * kt + fr) * TS + fq * 16;
        const bf16x8 x0 = *(const LAS bf16x8*)ka, x1 = *(const LAS bf16x8*)(ka + 64);
        f32x4 acc = {0.f, 0.f, 0.f, 0.f};
        acc = MFMA16(x0, qf0, acc); acc = MFMA16(x1, qf1, acc); S[kp] = acc;
    }
    constexpr float C2 = 0.125f * 1.4426950408889634f;
    float mx = -INFINITY;
#pragma unroll
    for (int kp = 0; kp < 9; ++kp) {
        const bool dead = (qb == 0) && (wid + kp < 8);
#pragma unroll
        for (int v = 0; v < 4; ++v) {
            bool ok = !dead;
            if (kp == 0) ok = ok && (fr <= 4 * fq + v);
            if (kp == 8) ok = ok && (fr >= 4 * fq + v);
            const float sc = ok ? S[kp][v] * C2 : -INFINITY; S[kp][v] = sc; mx = fmaxf(mx, sc);
        }
    }
    mx = fmaxf(mx, __shfl_xor(mx, 16)); mx = fmaxf(mx, __shfl_xor(mx, 32));
    float den = 0.f;
#pragma unroll
    for (int kp = 0; kp < 9; ++kp)
#pragma unroll
        for (int v = 0; v < 4; ++v) { const float p = __builtin_amdgcn_exp2f(S[kp][v] - mx); S[kp][v] = p; den += p; }
    den += __shfl_xor(den, 16); den += __shfl_xor(den, 32);
    S[9] = (f32x4){0.f, 0.f, 0.f, 0.f};
    f32x4 O[4];
#pragma unroll
    for (int dt = 0; dt < 4; ++dt) O[dt] = (f32x4){0.f, 0.f, 0.f, 0.f};
#pragma unroll
    for (int j = 0; j < 5; ++j) {
        u32x4 pw; pw.x = pk2(S[2 * j][0], S[2 * j][1]); pw.y = pk2(S[2 * j][2], S[2 * j][3]); pw.z = pk2(S[2 * j + 1][0], S[2 * j + 1][1]); pw.w = pk2(S[2 * j + 1][2], S[2 * j + 1][3]);
        const bf16x8 pf = __builtin_bit_cast(bf16x8, pw);
        const int kta = wid + 2 * j; int ktb = kta + 1; ktb = ktb > 15 ? 15 : ktb;
        LAS unsigned char* va = lds + LDS_VT + (16 * kta + 4 * fq + (fr >> 2)) * TS + (fr & 3) * 8;
        LAS unsigned char* vb = lds + LDS_VT + (16 * ktb + 4 * fq + (fr >> 2)) * TS + (fr & 3) * 8;
#pragma unroll
        for (int dt = 0; dt < 4; ++dt) {
            const s16x4 xa = tr_read(va + dt * 32), xb = tr_read(vb + dt * 32);
            const bf16x8 xf = __builtin_shufflevector(xa, xb, 0, 1, 2, 3, 4, 5, 6, 7);
            O[dt] = MFMA16(xf, pf, O[dt]);
        }
    }
    const float rden = __builtin_amdgcn_rcpf(den);
    bf16* op = OP + ((size_t)br * MPAD + rowq) * 512 + h * 64 + 4 * fq;
#pragma unroll
    for (int dt = 0; dt < 4; ++dt) { u32x2 o; o.x = pk2(O[dt][0] * rden, O[dt][1] * rden); o.y = pk2(O[dt][2] * rden, O[dt][3] * rden); *(u32x2*)(op + 16 * dt) = o; }
    if (fq == 0) LP[((size_t)br * MPAD + rowq) * 8 + h] = mx * 0.6931471805599453f + __logf(den);
}

__device__ __forceinline__ void spatial_unit(ArgsK a, LAS unsigned char* lds, int unit, int jl, int tid, int wid, int lane) {
    unsigned char* ws = AWS(a);
    const bf16* VBb = (const bf16*)(ws + WS_VB); const bf16* Zu = (const bf16*)(ws + WS_Z) + 1536; const bf16* WSP = (const bf16*)(ws + WS_WSP); bf16* CAT = (bf16*)(ws + WS_CAT);
    const int fr = lane & 15, fq = lane >> 4;
    const int b = unit >> 7, c = (unit >> 3) & 15, g = unit & 7;
    const size_t r0 = (size_t)b * SEQ + c * 128;
    { u32x4 sv[2];
#pragma unroll
      for (int it = 0; it < 2; ++it) { const int cc = tid + 512 * it, kr = cc >> 3, ch = cc & 7; sv[it] = *(const u32x4*)(VBb + (r0 + kr) * 512 + g * 64 + ch * 8); }
#pragma unroll
      for (int it = 0; it < 2; ++it) { const int cc = tid + 512 * it, kr = cc >> 3, ch = cc & 7; *(LAS u32x4*)(lds + LDS_VT + kr * TS + ch * 16) = sv[it]; } }
    __syncthreads();
    const int i = 16 * wid + fr;
    const bf16* wrow = WSP + ((size_t)(jl * 8 + g) * 128 + i) * 128;
    f32x4 O[4];
#pragma unroll
    for (int dt = 0; dt < 4; ++dt) O[dt] = (f32x4){0.f, 0.f, 0.f, 0.f};
    const int nks = (wid >> 1) + 1;
    for (int js = 0; js < nks; ++js) {
        const u32x2 wa = *(const u32x2*)(wrow + 32 * js + 4 * fq), wb = *(const u32x2*)(wrow + 32 * js + 16 + 4 * fq);
        u32x4 pw; pw.x = wa.x; pw.y = wa.y; pw.z = wb.x; pw.w = wb.y;
        const bf16x8 pf = __builtin_bit_cast(bf16x8, pw);
        LAS unsigned char* va = lds + LDS_VT + (32 * js + 4 * fq + (fr >> 2)) * TS + (fr & 3) * 8;
        LAS unsigned char* vb = va + 16 * TS;
#pragma unroll
        for (int dt = 0; dt < 4; ++dt) {
            const s16x4 xa = tr_read(va + dt * 32), xb = tr_read(vb + dt * 32);
            const bf16x8 xf = __builtin_shufflevector(xa, xb, 0, 1, 2, 3, 4, 5, 6, 7);
            O[dt] = MFMA16(xf, pf, O[dt]);
        }
    }
    const float bs = AIN(a, I_BSP)[(jl * 8 + g) * 128 + i];
    const bf16* up = Zu + (r0 + i) * ZW + g * 64 + 4 * fq; bf16* cp = CAT + (r0 + i) * DM + 512 + g * 64 + 4 * fq;
    u32x2 uq[4];
#pragma unroll
    for (int dt = 0; dt < 4; ++dt) uq[dt] = *(const u32x2*)(up + 16 * dt);
#pragma unroll
    for (int dt = 0; dt < 4; ++dt) {
        const u32x2 uu = uq[dt];
        u32x2 o; o.x = pk2(gelu_tanh(bflo(uu.x)) * (O[dt][0] + bs), gelu_tanh(bfhi(uu.x)) * (O[dt][1] + bs)); o.y = pk2(gelu_tanh(bflo(uu.y)) * (O[dt][2] + bs), gelu_tanh(bfhi(uu.y)) * (O[dt][3] + bs));
        *(u32x2*)(cp + 16 * dt) = o;
    }
}

__device__ __forceinline__ void sample_task(ArgsK a, LAS unsigned char* lds, int task, int jl, int tid, int wid, int lane) {
    unsigned char* ws = AWS(a);
    const bf16* Qb = (const bf16*)(ws + WS_Q); const bf16* Kb = (const bf16*)(ws + WS_K); const bf16* Zv = (const bf16*)(ws + WS_Z) + 1024; bf16* CAT = (bf16*)(ws + WS_CAT);
    const int n = task >> 3, h = task & 7; const size_t row = (size_t)MP + n;
    LAS float* qs = (LAS float*)(lds + 256 * wid);
    LAS float* part = (LAS float*)(lds + 4096);
    LAS float* fin = (LAS float*)(lds + 4096 + 8 * 3 * 68 * 4);
    const float qd = bflo((unsigned)Qb[row * 512 + h * 64 + lane]);
    qs[lane] = qd;
    const float* ck = AIN(a, I_CK) + ((size_t)(jl * MS + n) * 2048) * 512 + h * 64;
    const float* cv = AIN(a, I_CV) + ((size_t)(jl * MS + n) * 2048) * 512 + h * 64;
    const int br = (lane >> 4) > 2 ? 2 : (lane >> 4), el = lane & 15, dsh = 2 * br;
    const bool live = lane < 48;
    const int e = 16 * wid + el;
    const float* kr = ck + (size_t)(2048 - ((e + 1) << dsh)) * 512;
    float s = 0.f;
    { f32x4 kq[16];
#pragma unroll
      for (int c = 0; c < 16; ++c) kq[c] = *(const f32x4*)(kr + 4 * c);
#pragma unroll
      for (int c = 0; c < 16; ++c) { const f32x4 kv = kq[c]; const f32x4 qv = *(const LAS f32x4*)(qs + 4 * c); s += (kv.x * qv.x + kv.y * qv.y) + (kv.z * qv.z + kv.w * qv.w); } }
    s = live ? s * 0.125f : -INFINITY;
    float m = s;
#pragma unroll
    for (int o = 1; o < 16; o <<= 1) m = fmaxf(m, __shfl_xor(m, o));
    const float p = live ? __expf(s - m) : 0.f;
    float l = p;
#pragma unroll
    for (int o = 1; o < 16; o <<= 1) l += __shfl_xor(l, o);
    f32x4 o4 = {0.f, 0.f, 0.f, 0.f};
#pragma unroll
    for (int j = 0; j < 16; ++j) {
        const float pj = __shfl(p, (lane & 48) + j);
        const f32x4 v4 = *(const f32x4*)(cv + (size_t)(2048 - ((16 * wid + j + 1) << dsh)) * 512 + 4 * el);
        o4 += pj * v4;
    }
    if (live) { LAS float* pp = part + (wid * 3 + br) * 68; if (el == 0) { pp[0] = m; pp[1] = l; } *(LAS f32x4*)(pp + 4 + 4 * el) = o4; }
    __syncthreads();
    if (wid < 3) {
        const float kd = bflo((unsigned)Kb[row * 512 + h * 64 + lane]), vd = bflo((unsigned)Zv[row * ZW + h * 64 + lane]);
        const float s_new = wave_sum(qd * kd) * 0.125f;
        float M = s_new;
#pragma unroll
        for (int w = 0; w < 8; ++w) M = fmaxf(M, part[(w * 3 + wid) * 68]);
        float L = __expf(s_new - M), O = L * vd;
#pragma unroll
        for (int w = 0; w < 8; ++w) { const LAS float* pp = part + (w * 3 + wid) * 68; const float f = __expf(pp[0] - M); L += pp[1] * f; O += pp[4 + lane] * f; }
        LAS float* ff = fin + wid * 68; if (lane == 0) ff[0] = M + __logf(L); ff[4 + lane] = O / L;
    }
    __syncthreads();
    if (wid == 0) {
        const float l0 = fin[0], l1 = fin[68], l2 = fin[136]; const float mm = fmaxf(l0, fmaxf(l1, l2));
        const float e0 = __expf(l0 - mm), e1 = __expf(l1 - mm), e2 = __expf(l2 - mm);
        const float att = (e0 * fin[4 + lane] + e1 * fin[68 + 4 + lane] + e2 * fin[136 + 4 + lane]) / (e0 + e1 + e2);
        CAT[row * DM + h * 64 + lane] = (bf16)f2bf(att);
    }
}
__device__ __forceinline__ void sample_gate(ArgsK a, int jl, int gt, int ngt) {
    unsigned char* ws = AWS(a);
    const bf16* VBb = (const bf16*)(ws + WS_VB); const bf16* Zu = (const bf16*)(ws + WS_Z) + 1536; bf16* CAT = (bf16*)(ws + WS_CAT);
    for (int e = gt; e < MS * 512; e += ngt) {
        const int n = e >> 9, c = e & 511, g = c >> 6; const size_t row = (size_t)MP + n;
        const float w00 = AIN(a, I_WSP)[(size_t)(jl * 8 + g) * 128 * 128], b0 = AIN(a, I_BSP)[(jl * 8 + g) * 128];
        const float u = gelu_tanh(bflo((unsigned)Zu[row * ZW + c])), vb = bflo((unsigned)VBb[row * 512 + c]);
        CAT[row * DM + 512 + c] = (bf16)f2bf(u * (w00 * vb + b0));
    }
}

__device__ __forceinline__ float bfly32(const float (&v)[32], int lane) {
    float r16[16], r8[8], r4[4], r2[2];
    { const bool hi = lane & 32;
#pragma unroll
      for (int i = 0; i < 16; ++i) { const float keep = hi ? v[i + 16] : v[i], send = hi ? v[i] : v[i + 16]; r16[i] = keep + __shfl_xor(send, 32); } }
    { const bool hi = lane & 16;
#pragma unroll
      for (int i = 0; i < 8; ++i) { const float keep = hi ? r16[i + 8] : r16[i], send = hi ? r16[i] : r16[i + 8]; r8[i] = keep + __shfl_xor(send, 16); } }
    { const bool hi = lane & 8;
#pragma unroll
      for (int i = 0; i < 4; ++i) { const float keep = hi ? r8[i + 4] : r8[i], send = hi ? r8[i] : r8[i + 4]; r4[i] = keep + __shfl_xor(send, 8); } }
    { const bool hi = lane & 4;
#pragma unroll
      for (int i = 0; i < 2; ++i) { const float keep = hi ? r4[i + 2] : r4[i], send = hi ? r4[i] : r4[i + 2]; r2[i] = keep + __shfl_xor(send, 4); } }
    float r1; { const bool hi = lane & 2; const float keep = hi ? r2[1] : r2[0], send = hi ? r2[0] : r2[1]; r1 = keep + __shfl_xor(send, 2); }
    return r1 + __shfl_xor(r1, 1);
}
__device__ __forceinline__ void conv_phase(ArgsK a, LAS unsigned char* lds, int jl, int tid, int wid, int lane) {
    unsigned char* ws = AWS(a);
    const bf16* X = (const bf16*)(ws + WS_X); bf16* Y = (bf16*)(ws + WS_Y); const float* ZS = (const float*)(ws + WS_ZS);
    const int c0 = 2 * tid;
    float w0[31], w1[31];
#pragma unroll
    for (int w = 0; w < 31; ++w) { const float2 t = *(const float2*)(AIN(a, I_WDW) + (size_t)(jl * 31 + w) * DM + c0); w0[w] = t.x; w1[w] = t.y; }
    const float2 bd = *(const float2*)(AIN(a, I_BDW) + jl * DM + c0), gg = *(const float2*)(AIN(a, I_CG) + jl * DM + c0), be = *(const float2*)(AIN(a, I_CB) + jl * DM + c0);
    LAS float* red = (LAS float*)lds;
    LAS float* tot = (LAS float*)(lds + 2048);
    constexpr int CT = 32, NU = MP / CT;
    for (int unit = bidx(); unit < NU + MS; unit += gridDim.x) {
        if (unit < NU) {
            const int b = unit >> 6, t0 = (unit & 63) * CT; const bool lastu = (unit & 63) == 63;
            unsigned xu[CT + 30];
#pragma unroll
            for (int r = 0; r < CT + 30; ++r) { const int t = t0 - 30 + r, tc = t < 0 ? 0 : t; xu[r] = *(const unsigned*)(X + ((size_t)b * SEQ + tc) * DM + c0); }
            if (lastu) {
#pragma unroll
                for (int r = CT; r < CT + 30; ++r) { float2 o; o.x = bflo(xu[r]); o.y = bfhi(xu[r]); *(float2*)(AOUT(a) + O_CCP + ((size_t)(jl * NB + b) * 30 + (r - CT)) * DM + c0) = o; }
            }
#pragma unroll
            for (int hf = 0; hf < 2; ++hf) {
                float a0[16], a1[16];
#pragma unroll
                for (int tt = 0; tt < 16; ++tt) { a0[tt] = bd.x; a1[tt] = bd.y; }
#pragma unroll
                for (int rr = 0; rr < 46; ++rr) {
                    const int r = 16 * hf + rr, t = t0 - 30 + r;
                    const float x0 = t >= 0 ? bflo(xu[r]) : 0.f, x1 = t >= 0 ? bfhi(xu[r]) : 0.f;
#pragma unroll
                    for (int tt = 0; tt < 16; ++tt) { const int w = rr - tt; if (w >= 0 && w <= 30) { a0[tt] += x0 * w0[w]; a1[tt] += x1 * w1[w]; } }
                }
                {
                    float sv[32];
#pragma unroll
                    for (int tt = 0; tt < 16; ++tt) { sv[tt] = a0[tt] + a1[tt]; sv[16 + tt] = a0[tt] * a0[tt] + a1[tt] * a1[tt]; }
                    const float wt = bfly32(sv, lane);
                    if ((lane & 1) == 0) red[wid * 64 + (lane >> 1)] = wt;
                }
                __syncthreads();
                if (tid < 64) { float s = 0.f;
#pragma unroll
                    for (int w = 0; w < 8; ++w) s += red[w * 64 + tid];
                    tot[tid] = s; }
                __syncthreads();
#pragma unroll
                for (int tt = 0; tt < 16; ++tt) {
                    const float mean = tot[tt] * (1.f / DM), var = fmaxf(tot[tt + 16] * (1.f / DM) - mean * mean, 0.f), rstd = rsqrtf(var + EPS);
                    const float y0 = (a0[tt] - mean) * rstd * gg.x + be.x, y1 = (a1[tt] - mean) * rstd * gg.y + be.y;
                    const float z0 = y0 * __builtin_amdgcn_rcpf(1.f + __expf(-y0)), z1 = y1 * __builtin_amdgcn_rcpf(1.f + __expf(-y1));
                    *(unsigned*)(Y + ((size_t)b * SEQ + t0 + 16 * hf + tt) * DM + c0) = pk2(z0, z1);
                }
                __syncthreads();
            }
        } else {
            const int n = unit - NU;
            const int np = 256 * (c0 >> 7) + (c0 & 127);
            const float2 av = *(const float2*)(ZS + (size_t)n * 2048 + np), gv = *(const float2*)(ZS + (size_t)n * 2048 + np + 128);
            const float xn0 = av.x / (1.f + __expf(-gv.x)), xn1 = av.y / (1.f + __expf(-gv.y));
            float s0 = bd.x + xn0 * w0[30], s1 = bd.y + xn1 * w1[30];
            const float* st = AIN(a, I_CST) + ((size_t)(jl * MS + n) * 30) * DM + c0;
            float* oc = AOUT(a) + O_CCS + ((size_t)(jl * MS + n) * 30) * DM + c0;
            float2 sst[30];
#pragma unroll
            for (int w = 0; w < 30; ++w) sst[w] = *(const float2*)(st + (size_t)w * DM);
#pragma unroll
            for (int w = 0; w < 30; ++w) { const float2 sv = sst[w]; s0 += sv.x * w0[w]; s1 += sv.y * w1[w]; if (w >= 1) *(float2*)(oc + (size_t)(w - 1) * DM) = sv; }
            { float2 o; o.x = xn0; o.y = xn1; *(float2*)(oc + (size_t)29 * DM) = o; }
            const float s = wave_sum(s0 + s1), q = wave_sum(s0 * s0 + s1 * s1);
            if (lane == 0) { red[wid * 64] = s; red[wid * 64 + 16] = q; }
            __syncthreads();
            if (tid < 64) { float t = 0.f;
#pragma unroll
                for (int w = 0; w < 8; ++w) t += red[w * 64 + tid];
                tot[tid] = t; }
            __syncthreads();
            const float mean = tot[0] * (1.f / DM), var = fmaxf(tot[16] * (1.f / DM) - mean * mean, 0.f), rstd = rsqrtf(var + EPS);
            const float y0 = (s0 - mean) * rstd * gg.x + be.x, y1 = (s1 - mean) * rstd * gg.y + be.y;
            *(unsigned*)(Y + ((size_t)MP + n) * DM + c0) = pk2(y0 / (1.f + __expf(-y0)), y1 / (1.f + __expf(-y1)));
            __syncthreads();
        }
    }
}

template <class F> __device__ __forceinline__ void skinny_gemm(LAS unsigned char* lds, const bf16* A, const bf16* Bt, int N, int K, int tid, int wid, int lane, F f) {
    const int fr = lane & 15, fq = lane >> 4; LAS float* red = (LAS float*)lds;
    const int ks = K >> 3;
    for (int cgp = bidx(); cgp < (N >> 4); cgp += gridDim.x) {
        f32x4 acc0 = {0.f, 0.f, 0.f, 0.f}, acc1 = {0.f, 0.f, 0.f, 0.f};
        const bf16* a0p = A + (size_t)fr * K + wid * ks + fq * 8; const bf16* a1p = a0p + (size_t)16 * K; const bf16* bp = Bt + (size_t)(cgp * 16 + fr) * K + wid * ks + fq * 8;
        for (int kk = 0; kk < ks; kk += 128) {
            bf16x8 x[4], y0[4], y1[4];
#pragma unroll
            for (int q = 0; q < 4; ++q) { x[q] = *(const bf16x8*)(bp + kk + 32 * q); y0[q] = *(const bf16x8*)(a0p + kk + 32 * q); y1[q] = *(const bf16x8*)(a1p + kk + 32 * q); }
            __builtin_amdgcn_sched_barrier(0);
#pragma unroll
            for (int q = 0; q < 4; ++q) { acc0 = MFMA16(x[q], y0[q], acc0); acc1 = MFMA16(x[q], y1[q], acc1); }
        }
#pragma unroll
        for (int v = 0; v < 4; ++v) { red[(wid * 32 + fr) * 16 + 4 * fq + v] = acc0[v]; red[(wid * 32 + 16 + fr) * 16 + 4 * fq + v] = acc1[v]; }
        __syncthreads();
        { const int r = tid >> 4, c = tid & 15; float s = 0.f;
#pragma unroll
          for (int w = 0; w < 8; ++w) s += red[(w * 32 + r) * 16 + c];
          f(r, cgp * 16 + c, s); }
        __syncthreads();
    }
}
#ifndef MK_MULTI
#define MK_MULTI 0
#endif
constexpr int N_PHASES = 32;
#ifndef PH_MASK
#define PH_MASK 0xffff
#endif
#define PHON(k) ((PH_MASK >> (k)) & 1)
#ifndef REPEAT_MASK
#define REPEAT_MASK 0
#endif
__device__ __forceinline__ int fresh_tid(int wid0) { int t = wid0 * 64 + (int)__builtin_amdgcn_mbcnt_hi(~0u, __builtin_amdgcn_mbcnt_lo(~0u, 0u)); asm volatile("" : "+v"(t)); return t; }
__global__ void __launch_bounds__(512, 2) fwd_kernel(Args a_unused) {
    extern __shared__ __attribute__((aligned(16))) unsigned char lds_raw[];
    ArgsK ap0 = (ArgsK)__builtin_amdgcn_kernarg_segment_ptr();
    LAS unsigned char* lds = (LAS unsigned char*)lds_raw;
    cg::grid_group grid = cg::this_grid();
    const int wid0 = __builtin_amdgcn_readfirstlane((int)threadIdx.x >> 6);
    const int ph_lo = ap0->ph_lo, ph_hi = ap0->ph_hi;
    volatile LAS unsigned* bst = (volatile LAS unsigned*)(lds + LDS_BAR_OFF);
    if (threadIdx.x < 2) bst[threadIdx.x] = 0u;
    __syncthreads();
    XcdBarrier xbar; xbar.bar = (unsigned*)(AWS(ap0) + WS_BAR); xbar.x = 0; xbar.st = bst;
    if (ph_hi - ph_lo > 1) xbar = xcd_barrier_post((unsigned*)(AWS(ap0) + WS_BAR), bst);
    if (ph_lo < 0) grid.sync();
    for (int ph = ph_lo; ph < ph_hi; ++ph) {
        const int kind0 = ph - (ph >= 16 ? 16 : 0);
        if (ph != 0 && (kind0 == 0 || kind0 == 6 || kind0 == 9 || kind0 == 13)) continue;
        const int reps = ((REPEAT_MASK >> kind0) & 1) ? 2 : 1;
        for (int rep = 0; rep < reps; ++rep) {
        int phv = ph; asm volatile("" : "+s"(phv));
        const int half = phv >= 16 ? 1 : 0, kind = phv - 16 * half, L = 2 * half + (kind >= 9 ? 1 : 0), jl = half;
        const bool is_gemm = (kind == 1 || kind == 5 || kind == 7 || kind == 8 || kind == 10 || kind == 12 || kind == 14 || kind == 15);
        if (is_gemm) {
            {
                ArgsK ap = ap0; asm volatile("" : "+s"(ap));
                GemmCfg c; gemm_cfg(ap, phv, c);
                EpiAll E{ap0, phv};
                pg8::Gemm g{c.A, c.B, MP, c.N, c.K}; pg8::StaticOrder S; S.init(MP, c.N, (int)gridDim.x, bidx());
                pg8::gemm_phase<EpiAll, pg8::StaticOrder, true, true>(lds, g, S, E, fresh_tid(wid0));
            }
            {
                ArgsK ap = ap0; asm volatile("" : "+s"(ap));
                GemmCfg c; gemm_cfg(ap, phv, c);
                const int gmode = c.mode; bf16* gO = c.O; const int gld = c.ld; const rs_t* rs = c.rs; rs_t* rsn = c.rsn;
                const float* xs = c.xins; float* ys = c.yout + O_YS; bf16* hbs = c.hb + (size_t)MP * DM; const bool first = c.first, last = c.last;
                float* zs = (float*)(AWS(ap) + WS_ZS);
                const int tid = fresh_tid(wid0), wid = __builtin_amdgcn_readfirstlane(tid >> 6), lane = tid & 63;
                skinny_gemm(lds, c.A + (size_t)MP * c.K, c.B, c.N, c.K, tid, wid, lane, [=](int r, int cc, float v) {
                    if (gmode == 3) {
                        const float hv = (first ? xs[r * DM + cc] : bflo((unsigned)hbs[r * DM + cc])) + v;
                        if (last) ys[r * DM + cc] = hv; else hbs[r * DM + cc] = (bf16)f2bf(hv);
                        if (rsn) { float ss = hv * hv; ss += __shfl_xor(ss, 1); ss += __shfl_xor(ss, 2); ss += __shfl_xor(ss, 4); ss += __shfl_xor(ss, 8);
                            if ((cc & 15) == 0) atomicAdd(rsn + MP + r, rs_enc(ss)); }
                    } else {
                        const float sv = v * rs_scale(rs[MP + r]);
                        if (gmode == 2) zs[r * 2048 + cc] = sv;
                        else { const float t = fmaxf(sv, 0.f); gO[(size_t)(MP + r) * gld + cc] = (bf16)f2bf(gmode == 1 ? t * t : sv); }
                    }
                });
            }
            if (phv == 1 || phv == 17) {
                ArgsK ap = ap0; asm volatile("" : "+s"(ap));
                const int G = (int)gridDim.x, nrem = 640 % G, c = bidx();
                const bool all = (nrem == 0); const int nhelp = all ? G : G - nrem, hidx = all ? c : c - nrem;
                if (hidx >= 0) { const int tid = fresh_tid(wid0), wid = __builtin_amdgcn_readfirstlane(tid >> 6), lane = tid & 63; convert_set(ap, phv == 1 ? 1 : 2, hidx * 8 + wid, nhelp * 8, lane); }
            }
        } else {
            ArgsK a = ap0; asm volatile("" : "+s"(a));
            const int tid = fresh_tid(wid0), wid = __builtin_amdgcn_readfirstlane(tid >> 6), lane = tid & 63;
            switch (kind) {
            case 0: case 6: case 9: case 13: if (PHON(0)) {
                if (phv == 0 && rep == 0) { const int npro = ((REPEAT_MASK >> 16) & 1) ? 2 : 1; for (int q = 0; q < npro; ++q) { prologue(a, lds, tid, wid, lane); __syncthreads(); } }
            } break;
            case 2: if (PHON(2)) post_phase(a, jl, wid, lane); break;
            case 3: if (PHON(3)) {
                for (int rq = 0; rq < (((REPEAT_MASK >> 17) & 1) ? 2 : 1); ++rq) {
                    const int G = (int)gridDim.x, c = bidx(); const bool xmap = (G == 256);
                    const int nr = xmap ? 12 : (3072 - c + G - 1) / G;
                    u32x4 kvA[4], vvA[4], kvB[4], vvB[4]; bf16x8 qA0 = {0, 0, 0, 0, 0, 0, 0, 0}, qA1 = qA0, qB0 = qA0, qB1 = qA0;
#pragma unroll
                    for (int i = 0; i < 4; ++i) { kvA[i] = (u32x4){0u, 0u, 0u, 0u}; vvA[i] = kvA[i]; kvB[i] = kvA[i]; vvB[i] = kvA[i]; }
#define ATT_UNIT(r_) (xmap ? ((((r_) * 32 + (c >> 3)) >> 7) * 1024 + (((((((r_) * 32 + (c >> 3)) >> 4) & 7) << 3) + (c & 7)) << 4) + (((r_) * 32 + (c >> 3)) & 15)) : (c + (r_) * G))
                    constexpr int ABUF = 2 * 256 * TS;
                    if (nr > 0) { const int u0 = ATT_UNIT(0); attn_load(a, u0, tid, kvA, vvA); attn_loadq(a, u0, wid, lane, qA0, qA1); }
                    if (nr > 1) { const int u1 = ATT_UNIT(1); attn_load(a, u1, tid, kvB, vvB); attn_loadq(a, u1, wid, lane, qB0, qB1); }
                    __syncthreads();
                    if (nr > 0) attn_stage(lds, tid, kvA, vvA);
                    __syncthreads();
#pragma unroll 1
                    for (int r = 0; r < nr; r += 2) {
                        {
                            const int u = ATT_UNIT(r); const bf16x8 qf0 = qA0, qf1 = qA1;
                            if (r + 1 < nr) attn_stage(lds + ABUF, tid, kvB, vvB);
                            if (r + 2 < nr) { const int un = ATT_UNIT(r + 2); attn_load(a, un, tid, kvA, vvA); attn_loadq(a, un, wid, lane, qA0, qA1); }
                            attn_compute(a, lds, u, wid, lane, qf0, qf1);
                            __syncthreads();
                        }
                        if (r + 1 < nr) {
                            const int u = ATT_UNIT(r + 1); const bf16x8 qf0 = qB0, qf1 = qB1;
                            if (r + 2 < nr) attn_stage(lds, tid, kvA, vvA);
                            if (r + 3 < nr) { const int un = ATT_UNIT(r + 3); attn_load(a, un, tid, kvB, vvB); attn_loadq(a, un, wid, lane, qB0, qB1); }
                            attn_compute(a, lds + ABUF, u, wid, lane, qf0, qf1);
                            __syncthreads();
                        }
                    }
#undef ATT_UNIT
                }
                for (int rq = 0; rq < (((REPEAT_MASK >> 18) & 1) ? 2 : 1); ++rq)
                for (int u = bidx(); u < 1024; u += gridDim.x) { __syncthreads(); spatial_unit(a, lds, u, jl, tid, wid, lane); }
                for (int rq = 0; rq < (((REPEAT_MASK >> 19) & 1) ? 2 : 1); ++rq)
                for (int u = bidx(); u < MS * 8; u += gridDim.x) { __syncthreads(); sample_task(a, lds, u, jl, tid, wid, lane); }
                sample_gate(a, jl, bidx() * 512 + tid, gridDim.x * 512);
            } break;
            case 4: if (PHON(4)) combine_phase(a, wid, lane); break;
            case 11: if (PHON(11)) conv_phase(a, lds, jl, tid, wid, lane); break;
            default: break;
            }
        }
        if (rep + 1 < reps) __syncthreads();
        }
#ifndef SYNC_REPS
#define SYNC_REPS 1
#endif
        if (ph + 1 < ph_hi) { for (int q = 0; q < SYNC_REPS; ++q) { XcdBarrier b2 = xbar; asm volatile("" : "+s"(b2.bar)); xcd_barrier(b2); } }
    }
}

extern "C" void kernel_launch(void* const* d_in, const int* in_sizes, int n_in, void* d_out, int out_size, void* d_ws, size_t ws_size, hipStream_t stream) {
    static int grid = 0;
    if (grid == 0) {
        if (n_in != 23 || (size_t)out_size != O_END || ws_size < WS_END) { fprintf(stderr, "kernel_launch: unexpected sizes n_in %d out %d ws %zu\n", n_in, out_size, ws_size); grid = -1; return; }
        int dev = 0, cus = 0, per_cu = 0;
        (void)hipGetDevice(&dev); (void)hipDeviceGetAttribute(&cus, hipDeviceAttributeMultiprocessorCount, dev);
        if (hipFuncSetAttribute((const void*)fwd_kernel, hipFuncAttributeMaxDynamicSharedMemorySize, LDS_BYTES) != hipSuccess) { fprintf(stderr, "kernel_launch: hipFuncSetAttribute failed\n"); grid = -1; return; }
        if (hipOccupancyMaxActiveBlocksPerMultiprocessor(&per_cu, (const void*)fwd_kernel, 512, LDS_BYTES) != hipSuccess || per_cu < 1) { fprintf(stderr, "kernel_launch: occupancy query failed (%d)\n", per_cu); (void)hipGetLastError(); per_cu = 1; }
        grid = cus * per_cu;
        if (grid <= 0) grid = 256;
    }
    if (grid < 0) return;
    if (hipMemsetAsync((char*)d_ws + WS_BAR, 0, 16384, stream) != hipSuccess) { fprintf(stderr, "kernel_launch: memset of barrier words failed\n"); return; }
    Args a{};
    for (int i = 0; i < 23; ++i) a.in[i] = (GAS const float*)d_in[i];
    a.out = (GAS float*)d_out; a.ws = (GAS unsigned char*)d_ws;
#if MK_MULTI
    for (int ph = 0; ph < N_PHASES; ++ph) { a.ph_lo = ph; a.ph_hi = ph + 1; hipLaunchKernelGGL(fwd_kernel, dim3(grid), dim3(512), LDS_BYTES, stream, a); }
#else
    a.ph_lo = 0; a.ph_hi = N_PHASES;
    void* args[] = {&a};
    hipError_t e = hipLaunchCooperativeKernel((const void*)fwd_kernel, dim3(grid), dim3(512), args, LDS_BYTES, stream);
    if (e != hipSuccess) fprintf(stderr, "cooperative launch failed: %s (grid %d)\n", hipGetErrorString(e), grid);
#endif
}
```

```cpp
#include <hip/hip_runtime.h>
#include <hip/hip_cooperative_groups.h>
#include <cstdio>
#include <cstdint>
#include <cmath>
namespace cg = cooperative_groups;
namespace pg8 {
#define PG8_LAS __attribute__((address_space(3)))
typedef unsigned short bf16_t;
typedef short bf16x8 __attribute__((ext_vector_type(8)));
typedef float f32x4 __attribute__((ext_vector_type(4)));
typedef unsigned u32x4 __attribute__((ext_vector_type(4)));
constexpr int BM = 256, BK = 64, HALF = 128, HTB = HALF * BK * 2  , STAGE_BYTES = 8 * HTB, NXCD = 8, WGM = 4;

__host__ __device__ __forceinline__ int lds_byte(int r, int c) { const int st = (r >> 4) * 2 + (c >> 5), rr = r & 15, cc = c & 31, ob = rr * 64 + cc * 2; return st * 1024 + (ob ^ (((ob >> 9) & 1) << 5)); }
__host__ __device__ __forceinline__ void stage_rc(int b, int& R, int& C) { const int st = b / 1024, sb = b % 1024, swz = sb ^ (((sb >> 9) & 1) << 5); R = (st >> 1) * 16 + swz / 64; C = (st & 1) * 32 + (swz % 64) / 2; }
__host__ __device__ __forceinline__ int perm32(int rho) { const int n = rho >> 4, i = rho & 15; return 8 * (i >> 2) + 4 * n + (i & 3); }

struct Unit { int pm, pn; };
struct Gemm { const bf16_t* A; const bf16_t* Bt; int M, N, K; };

struct StaticOrder {
    int nM, nN, nwg, G, c;
    __host__ __device__ void init(int M, int N, int G_, int c_) { nM = M / BM; nN = N / BM; nwg = nM * nN; G = G_; c = c_; }
    __host__ __device__ bool next(int i, Unit& u) const {
        const long L = (long)i * G + c; if (L >= nwg) return false;
        int wgid = (int)L; { const int q = nwg / NXCD, r = nwg % NXCD, xcd = wgid % NXCD, off = wgid / NXCD; wgid = (xcd < r ? xcd * (q + 1) : r * (q + 1) + (xcd - r) * q) + off; }
        const int nig = WGM * nN, gid = wgid / nig, fm = gid * WGM, gsz = (nM - fm) < WGM ? (nM - fm) : WGM;
        u.pm = fm + ((wgid % nig) % gsz); u.pn = (wgid % nig) / gsz; return true;
    }
    __device__ __forceinline__ void a_ready(const Unit&) const {}
    __device__ __forceinline__ void done(const Unit&) const {}
};
typedef float f32x2 __attribute__((ext_vector_type(2)));
typedef __bf16 bf16x2v __attribute__((ext_vector_type(2)));
__device__ __forceinline__ unsigned pkbf(float lo, float hi) { f32x2 v = {lo, hi}; bf16x2v b = __builtin_convertvector(v, bf16x2v); return __builtin_bit_cast(unsigned, b); }
template <class Epi, class Sched, bool ALIGN_EPI = false, bool SP2 = false>
__device__ __forceinline__ void gemm_phase(PG8_LAS unsigned char* lds, const Gemm g, const Sched& S, const Epi& E, const int tid_in) {
    const int tid = tid_in, wid = __builtin_amdgcn_readfirstlane(tid >> 6), lane = tid & 63, wr = wid >> 2, wc = wid & 3, fr = lane & 15, fq = lane >> 4;
    const int K = g.K, nt = K / BK;
    unsigned voffA[2], voffB[2];
#pragma unroll
    for (int i = 0; i < 2; ++i) { int R, C; stage_rc(tid * 16 + i * 8192, R, C); const int Rb = Epi::PERM ? ((R & ~31) + perm32(R & 31)) : R;
        voffA[i] = (unsigned)(R * K + C) * 2u; voffB[i] = (unsigned)(Rb * K + C) * 2u; }
    const size_t kstep = (size_t)(BK * 2);
    const size_t hstep = (size_t)HALF * K * 2;
    const size_t tstep = 2 * hstep;
    const unsigned ldsw = (unsigned)wid * 1024u;
    const int aoff = lds_byte(wr * 64 + fr, fq * 8), boff = lds_byte(wc * 32 + fr, fq * 8);
#define PG8_SA(b, h) (((b) * 2 + (h)) * HTB)
#define PG8_SB(b, h) ((4 + (b) * 2 + (h)) * HTB)
#define PG8_STAGE(bufoff, gbase, voff) do { _Pragma("unroll") for (int _i = 0; _i < 2; ++_i) \
        __builtin_amdgcn_global_load_lds((const unsigned*)((const char*)(gbase) + (voff)[_i]), (PG8_LAS unsigned*)(lds + (bufoff) + ldsw + _i * 8192), 16, 0, 0); } while (0)
#define PG8_LDA(dst, b, h) do { _Pragma("unroll") for (int m = 0; m < 4; ++m) _Pragma("unroll") for (int k = 0; k < 2; ++k) dst[m][k] = *(const PG8_LAS bf16x8*)(lds + PG8_SA(b, h) + aoff + m * 2048 + k * 1024); } while (0)
#define PG8_LDB(dst, b, h) do { _Pragma("unroll") for (int n = 0; n < 2; ++n) _Pragma("unroll") for (int k = 0; k < 2; ++k) dst[n][k] = *(const PG8_LAS bf16x8*)(lds + PG8_SB(b, h) + boff + n * 2048 + k * 1024); } while (0)
#define PG8_MMA(ai, bj, At, Bt) do { __builtin_amdgcn_s_setprio(1); _Pragma("unroll") for (int m = 0; m < 4; ++m) _Pragma("unroll") for (int n = 0; n < 2; ++n) _Pragma("unroll") for (int k = 0; k < 2; ++k) \
        acc[ai][bj][m][n] = __builtin_amdgcn_mfma_f32_16x16x32_bf16(Bt[n][k], At[m][k], acc[ai][bj][m][n], 0, 0, 0); __builtin_amdgcn_s_setprio(0); } while (0)
#define PG8_WAIT_V(n) asm volatile("s_waitcnt vmcnt(" #n ")" ::: "memory")
#define PG8_WAIT_L(n) asm volatile("s_waitcnt lgkmcnt(" #n ")" ::: "memory")
#define PG8_BAR __builtin_amdgcn_s_barrier()
#define PG8_SCHED __builtin_amdgcn_sched_barrier(0)
    Unit cur, nxt; int ui = 0;
    if (!S.next(0, cur)) return;
    f32x4 acc[2][2][4][2];
#pragma unroll
    for (int a = 0; a < 2; ++a)
#pragma unroll
        for (int b = 0; b < 2; ++b)
#pragma unroll
            for (int m = 0; m < 4; ++m)
#pragma unroll
                for (int n = 0; n < 2; ++n) acc[a][b][m][n] = (f32x4){0.f, 0.f, 0.f, 0.f};
    bf16x8 At[4][2], B0[2][2], B1[2][2];
    const char* cA = (const char*)g.A + (size_t)cur.pm * tstep; const char* cB = (const char*)g.Bt + (size_t)cur.pn * tstep;
    S.a_ready(cur);
    if constexpr (SP2) {
        PG8_STAGE(PG8_SB(0, 0), cB, voffB); PG8_STAGE(PG8_SB(0, 1), cB + hstep, voffB); PG8_STAGE(PG8_SA(0, 0), cA, voffA); PG8_STAGE(PG8_SA(0, 1), cA + hstep, voffA);
        if (wr == 1) PG8_BAR;
        PG8_WAIT_V(2); PG8_BAR;
        PG8_STAGE(PG8_SB(1, 0), cB + kstep, voffB); PG8_STAGE(PG8_SA(1, 0), cA + kstep, voffA); PG8_STAGE(PG8_SB(1, 1), cB + hstep + kstep, voffB);
        PG8_WAIT_V(6); PG8_BAR;
    } else {
        PG8_STAGE(PG8_SB(0, 0), cB, voffB); PG8_STAGE(PG8_SA(0, 0), cA, voffA); PG8_STAGE(PG8_SB(0, 1), cB + hstep, voffB); PG8_STAGE(PG8_SA(0, 1), cA + hstep, voffA);
        if (wr == 1) PG8_BAR;
        PG8_WAIT_V(4); PG8_BAR;
        PG8_STAGE(PG8_SB(1, 0), cB + kstep, voffB); PG8_STAGE(PG8_SA(1, 0), cA + kstep, voffA); PG8_STAGE(PG8_SB(1, 1), cB + hstep + kstep, voffB);
        PG8_WAIT_V(6); PG8_BAR;
    }
    for (;;) {
        const bool has_next = S.next(ui + 1, nxt);
        const char* nA = has_next ? (const char*)g.A + (size_t)nxt.pm * tstep : cA; const char* nB = has_next ? (const char*)g.Bt + (size_t)nxt.pn * tstep : cB;
        for (int t = 0; t < nt; t += 2) {
            const bool last = (t == nt - 2);
            const char* a1 = cA + (size_t)(t + 1) * kstep;
            const char* a2 = last ? nA : cA + (size_t)(t + 2) * kstep; const char* b2 = last ? nB : cB + (size_t)(t + 2) * kstep;
            const char* a3 = a2 + kstep; const char* b3 = b2 + kstep;
            if (last && has_next) S.a_ready(nxt);
            if constexpr (SP2) {
            PG8_LDB(B0, 0, 0); PG8_LDB(B1, 0, 1); PG8_SCHED; PG8_LDA(At, 0, 0); PG8_STAGE(PG8_SA(1, 1), a1 + hstep, voffA);
            PG8_WAIT_V(8); PG8_WAIT_L(0); PG8_BAR; PG8_MMA(0, 0, At, B0); PG8_MMA(0, 1, At, B1); PG8_BAR; PG8_SCHED;
            PG8_LDA(At, 0, 1); PG8_STAGE(PG8_SB(0, 0), b2, voffB); PG8_STAGE(PG8_SB(0, 1), b2 + hstep, voffB); PG8_STAGE(PG8_SA(0, 0), a2, voffA);
            PG8_WAIT_V(8); PG8_WAIT_L(0); PG8_BAR; PG8_MMA(1, 0, At, B0); PG8_MMA(1, 1, At, B1); PG8_BAR; PG8_SCHED;
            PG8_LDB(B0, 1, 0); PG8_LDB(B1, 1, 1); PG8_SCHED; PG8_LDA(At, 1, 0); PG8_STAGE(PG8_SA(0, 1), a2 + hstep, voffA);
            PG8_WAIT_V(8); PG8_WAIT_L(0); PG8_BAR; PG8_MMA(0, 0, At, B0); PG8_MMA(0, 1, At, B1); PG8_BAR; PG8_SCHED;
            PG8_LDA(At, 1, 1); PG8_STAGE(PG8_SB(1, 0), b3, voffB); PG8_STAGE(PG8_SB(1, 1), b3 + hstep, voffB); PG8_STAGE(PG8_SA(1, 0), a3, voffA);
            PG8_WAIT_V(8); PG8_WAIT_L(0); PG8_BAR; PG8_MMA(1, 0, At, B0); PG8_MMA(1, 1, At, B1); PG8_BAR; PG8_SCHED;
            } else {
            PG8_LDB(B0, 0, 0); PG8_SCHED; PG8_LDA(At, 0, 0); PG8_STAGE(PG8_SA(1, 1), a1 + hstep, voffA);
            PG8_WAIT_L(8); PG8_BAR; PG8_WAIT_L(0); PG8_MMA(0, 0, At, B0); PG8_BAR; PG8_SCHED;
            PG8_LDB(B1, 0, 1); PG8_STAGE(PG8_SB(0, 0), b2, voffB);
            PG8_BAR; PG8_WAIT_L(0); PG8_MMA(0, 1, At, B1); PG8_BAR;
            PG8_LDA(At, 0, 1); PG8_STAGE(PG8_SA(0, 0), a2, voffA);
            PG8_BAR; PG8_WAIT_L(0); PG8_MMA(1, 0, At, B0); PG8_BAR; PG8_SCHED;
            PG8_STAGE(PG8_SB(0, 1), b2 + hstep, voffB);
            PG8_WAIT_V(6); PG8_BAR; PG8_MMA(1, 1, At, B1); PG8_BAR;
            PG8_LDB(B0, 1, 0); PG8_SCHED; PG8_LDA(At, 1, 0); PG8_STAGE(PG8_SA(0, 1), a2 + hstep, voffA);
            PG8_WAIT_L(8); PG8_BAR; PG8_WAIT_L(0); PG8_MMA(0, 0, At, B0); PG8_BAR; PG8_SCHED;
            PG8_LDB(B1, 1, 1); PG8_STAGE(PG8_SB(1, 0), b3, voffB);
            PG8_BAR; PG8_WAIT_L(0); PG8_MMA(0, 1, At, B1); PG8_BAR;
            PG8_LDA(At, 1, 1); PG8_STAGE(PG8_SA(1, 0), a3, voffA);
            PG8_BAR; PG8_WAIT_L(0); PG8_MMA(1, 0, At, B0); PG8_BAR; PG8_SCHED;
            PG8_STAGE(PG8_SB(1, 1), b3 + hstep, voffB);
            PG8_WAIT_V(6); PG8_BAR; PG8_MMA(1, 1, At, B1); PG8_BAR;
            }
        }
        if constexpr (ALIGN_EPI) { if (wr == 0) PG8_BAR; }
        if constexpr (!Epi::AFTER_DRAIN) { int fr2 = fr, fq2 = fq; asm volatile("" : "+v"(fr2), "+v"(fq2));   E(acc, cur, wr, wc, fr2, fq2); S.done(cur); }
        if (!has_next) break;
#pragma unroll
        for (int a = 0; a < 2; ++a)
#pragma unroll
            for (int b = 0; b < 2; ++b)
#pragma unroll
                for (int m = 0; m < 4; ++m)
#pragma unroll
                    for (int n = 0; n < 2; ++n) acc[a][b][m][n] = (f32x4){0.f, 0.f, 0.f, 0.f};
        cur = nxt; cA = nA; cB = nB; ++ui;
        if constexpr (ALIGN_EPI) { if (wr == 1) PG8_BAR; }
    }
    PG8_WAIT_V(0);
    if constexpr (!ALIGN_EPI) { if (wr == 0) PG8_BAR; }
    PG8_BAR;
    if constexpr (Epi::AFTER_DRAIN) { E.fused(acc, cur, wr, wc, fr, fq, lds, wid, lane); S.done(cur); }
#undef PG8_SA
#undef PG8_SB
#undef PG8_STAGE
#undef PG8_LDA
#undef PG8_LDB
#undef PG8_MMA
#undef PG8_WAIT_V
#undef PG8_WAIT_L
#undef PG8_BAR
#undef PG8_SCHED
}
}
#define LAS __attribute__((address_space(3)))
typedef unsigned short bf16;
typedef short bf16x8 __attribute__((ext_vector_type(8)));
typedef short s16x4 __attribute__((ext_vector_type(4)));
typedef float f32x4 __attribute__((ext_vector_type(4)));
typedef unsigned u32x4 __attribute__((ext_vector_type(4)));
typedef unsigned u32x2 __attribute__((ext_vector_type(2)));

constexpr int DM = 1024, MP = 16384, MS = 32, MT = MP + MS, MPAD = 16640, SEQ = 2048, NB = 8;
constexpr int ZW = 2560, FF = 4096;
constexpr float EPS = 1e-6f;
constexpr size_t O_YP = 0, O_YS = 16777216, O_AKP = 16809984, O_AVP = 33587200, O_AKS = 50364416, O_AVS = 50397184,
                 O_BVP = 50429952, O_BVS = 51478528, O_CCP = 51511296, O_CCS = 52002816, O_END = 53968896;
constexpr size_t MiB = 1u << 20;
constexpr size_t WS_ROPE = 1 * MiB, WS_WSP = 2 * MiB, WS_ZS = 3 * MiB, WS_RS = 4 * MiB;
constexpr size_t WS_WUP = 8 * MiB, WS_WDN = 40 * MiB, WS_WIN = 72 * MiB, WS_WOUT = 82 * MiB, WS_WCI = 86 * MiB, WS_WCO = 94 * MiB;
constexpr size_t WS_N = 100 * MiB, WS_Z = 134 * MiB, WS_Q = 216 * MiB, WS_K = 233 * MiB, WS_V = 250 * MiB, WS_U = 267 * MiB, WS_VB = 284 * MiB;
constexpr size_t WS_OP = 301 * MiB, WS_LP = 350 * MiB, WS_CAT = 352 * MiB, WS_HID = 386 * MiB, WS_X = 516 * MiB, WS_Y = 550 * MiB, WS_END = 584 * MiB;
constexpr int LDS_BYTES = 163840, LDS_BAR_OFF = 148480;
constexpr size_t WS_BAR = 0;

typedef unsigned long long rs_t;
__device__ __forceinline__ rs_t rs_enc(float s) { return (rs_t)(s * 1048576.f + 0.5f); }
__device__ __forceinline__ float rs_scale(rs_t v) { return rsqrtf((float)v * (1.f / (1048576.f * 1024.f)) + 1e-6f); }
#define GAS __attribute__((address_space(1)))
struct Args { GAS const float* in[23]; GAS float* out; GAS unsigned char* ws; int ph_lo, ph_hi; };
typedef const __attribute__((address_space(4))) Args* ArgsK;
#define AIN(a, i) ((const float*)(a)->in[i])
#define AWS(a) ((unsigned char*)(a)->ws)
#define AOUT(a) ((float*)(a)->out)
enum { I_XP = 0, I_XS, I_CK, I_CV, I_CST, I_GMIX, I_GFFN, I_WUP, I_WDN, I_WIN, I_QG, I_KG, I_VBG, I_VBB, I_WSP, I_BSP, I_WOUT, I_WCI, I_WDW, I_BDW, I_CG, I_CB, I_WCO };

__device__ __forceinline__ int bidx() { int b = (int)blockIdx.x; asm volatile("" : "+s"(b)); return b; }
__device__ __forceinline__ float wave_sum(float v) {
#pragma unroll
    for (int o = 1; o < 64; o <<= 1) v += __shfl_xor(v, o);
    return v;
}
__device__ __forceinline__ float wave_max(float v) {
#pragma unroll
    for (int o = 1; o < 64; o <<= 1) v = fmaxf(v, __shfl_xor(v, o));
    return v;
}
__device__ __forceinline__ float bflo(unsigned u) { return __uint_as_float(u << 16); }
__device__ __forceinline__ float bfhi(unsigned u) { return __uint_as_float(u & 0xffff0000u); }
__device__ __forceinline__ unsigned f2bf(float f) { unsigned u = __float_as_uint(f); return (u + 0x7fffu + ((u >> 16) & 1u)) >> 16; }
__device__ __forceinline__ unsigned pk2(float lo, float hi) { return pg8::pkbf(lo, hi); }
__device__ __forceinline__ float gelu_tanh(float x) {
    const float y = 0.7978845608028654f * (x + 0.044715f * x * x * x);
    const float t = 1.f - 2.f * __builtin_amdgcn_rcpf(__expf(2.f * y) + 1.f);
    return 0.5f * x * (1.f + t);
}

__device__ __forceinline__ void transpose_item(const float* W, int K, int N, bf16* WT, bool glu, const float* gk, int item, int lane) {
    const int nblk = N / 32, i0 = 2 * item, kb = i0 / nblk, nb = i0 % nblk, k0 = 64 * kb, n0 = 32 * nb;
    const int nq = lane & 7, kq = lane >> 3;
    const float* src = W + (size_t)(k0 + 8 * kq) * N + n0 + 4 * nq;
    f32x4 v[2][8];
#pragma unroll
    for (int h2 = 0; h2 < 2; ++h2)
#pragma unroll
        for (int i = 0; i < 8; ++i) v[h2][i] = __builtin_nontemporal_load((const f32x4*)(src + (size_t)i * N + 32 * h2));
    if (gk) {
        const f32x4 ga = *(const f32x4*)(gk + k0 + 8 * kq), gb = *(const f32x4*)(gk + k0 + 8 * kq + 4);
#pragma unroll
        for (int h2 = 0; h2 < 2; ++h2)
#pragma unroll
            for (int i = 0; i < 4; ++i) { v[h2][i] = v[h2][i] * ga[i]; v[h2][4 + i] = v[h2][4 + i] * gb[i]; }
    }
#pragma unroll
    for (int h2 = 0; h2 < 2; ++h2) {
        const int nn = n0 + 32 * h2;
        const int d0 = glu ? (256 * ((nn & 1023) >> 7) + 128 * (nn >> 10) + (nn & 127)) : nn;
        bf16* dst = WT + (size_t)(d0 + 4 * nq) * K + k0 + 8 * kq;
#pragma unroll
        for (int j = 0; j < 4; ++j) { u32x4 o; o.x = pk2(v[h2][0][j], v[h2][1][j]); o.y = pk2(v[h2][2][j], v[h2][3][j]); o.z = pk2(v[h2][4][j], v[h2][5][j]); o.w = pk2(v[h2][6][j], v[h2][7][j]);
            *(u32x4*)(dst + (size_t)j * K) = o; }
    }
}

__device__ __forceinline__ void convert_set(ArgsK a, int set, int widx, int nw, int lane) {
    unsigned char* ws = AWS(a);
    constexpr int IPL[6] = {16 * 64, 64 * 16, 16 * 40, 16 * 16, 16 * 32, 16 * 16};
    int l0[6], l1[6];
    if (set == 0)      { l0[0] = 0; l1[0] = 0; l0[1] = 0; l1[1] = 0; l0[2] = 0; l1[2] = 1; l0[3] = 0; l1[3] = 0; l0[4] = 0; l1[4] = 0; l0[5] = 0; l1[5] = 0; }
    else if (set == 1) { l0[0] = 0; l1[0] = 2; l0[1] = 0; l1[1] = 2; l0[2] = 1; l1[2] = 2; l0[3] = 0; l1[3] = 1; l0[4] = 0; l1[4] = 1; l0[5] = 0; l1[5] = 1; }
    else               { l0[0] = 2; l1[0] = 4; l0[1] = 2; l1[1] = 4; l0[2] = 0; l1[2] = 0; l0[3] = 1; l1[3] = 2; l0[4] = 1; l1[4] = 2; l0[5] = 1; l1[5] = 2; }
    int cnt[6], total = 0;
#pragma unroll
    for (int m = 0; m < 6; ++m) { cnt[m] = (l1[m] - l0[m]) * IPL[m]; total += cnt[m]; }
    for (int it = widx; it < total; it += nw) {
        int r = it;
        if (r < cnt[0]) { const int l = l0[0] + r / IPL[0]; transpose_item(AIN(a, I_WUP) + (size_t)l * DM * FF, DM, FF, (bf16*)(ws + WS_WUP) + (size_t)l * DM * FF, false, AIN(a, I_GFFN) + l * DM, r % IPL[0], lane); continue; } r -= cnt[0];
        if (r < cnt[1]) { const int l = l0[1] + r / IPL[1]; transpose_item(AIN(a, I_WDN) + (size_t)l * DM * FF, FF, DM, (bf16*)(ws + WS_WDN) + (size_t)l * DM * FF, false, nullptr, r % IPL[1], lane); continue; } r -= cnt[1];
        if (r < cnt[2]) { const int l = l0[2] + r / IPL[2]; transpose_item(AIN(a, I_WIN) + (size_t)l * DM * ZW, DM, ZW, (bf16*)(ws + WS_WIN) + (size_t)l * DM * ZW, false, AIN(a, I_GMIX) + 2 * l * DM, r % IPL[2], lane); continue; } r -= cnt[2];
        if (r < cnt[3]) { const int l = l0[3] + r / IPL[3]; transpose_item(AIN(a, I_WOUT) + (size_t)l * DM * DM, DM, DM, (bf16*)(ws + WS_WOUT) + (size_t)l * DM * DM, false, nullptr, r % IPL[3], lane); continue; } r -= cnt[3];
        if (r < cnt[4]) { const int l = l0[4] + r / IPL[4]; transpose_item(AIN(a, I_WCI) + (size_t)l * DM * 2048, DM, 2048, (bf16*)(ws + WS_WCI) + (size_t)l * DM * 2048, true, AIN(a, I_GMIX) + (2 * l + 1) * DM, r % IPL[4], lane); continue; } r -= cnt[4];
        { const int l = l0[5] + r / IPL[5]; transpose_item(AIN(a, I_WCO) + (size_t)l * DM * DM, DM, DM, (bf16*)(ws + WS_WCO) + (size_t)l * DM * DM, false, nullptr, r % IPL[5], lane); }
    }
}

__device__ __forceinline__ void prologue(ArgsK a, LAS unsigned char* lds, int tid, int wid, int lane) {
    unsigned char* ws = AWS(a);
    const int gw = bidx() * 8 + wid, NGW = gridDim.x * 8;
    convert_set(a, 0, gw, NGW, lane);
    { rs_t* rs = (rs_t*)(ws + WS_RS); const int gt0 = bidx() * 512 + tid, NGT0 = gridDim.x * 512;
      for (int e = gt0; e < 7 * MPAD; e += NGT0) rs[MPAD + e] = 0ull; }
    { bf16* nout = (bf16*)(ws + WS_N); rs_t* rs0 = (rs_t*)(ws + WS_RS);
      for (int row = gw; row < MT; row += NGW) {
        const float* src = (row < MP) ? AIN(a, I_XP) + (size_t)row * DM : AIN(a, I_XS) + (size_t)(row - MP) * DM;
        f32x4 v[4]; float s = 0.f;
#pragma unroll
        for (int j = 0; j < 4; ++j) v[j] = *(const f32x4*)(src + 4 * lane + 256 * j);
        __builtin_amdgcn_sched_barrier(0);
#pragma unroll
        for (int j = 0; j < 4; ++j) s += (v[j].x * v[j].x + v[j].y * v[j].y) + (v[j].z * v[j].z + v[j].w * v[j].w);
        s = wave_sum(s); if (lane == 0) rs0[row] = rs_enc(s);
        bf16* dst = nout + (size_t)row * DM;
#pragma unroll
        for (int j = 0; j < 4; ++j) { u32x2 o; o.x = pk2(v[j].x, v[j].y); o.y = pk2(v[j].z, v[j].w); *(u32x2*)(dst + 4 * lane + 256 * j) = o; }
      } }
    const int gt = bidx() * 512 + tid, NGT = gridDim.x * 512;
    for (int e = gt; e < 2049 * 32; e += NGT) {
        const int pi = e >> 5, i = e & 31; const float pos = (pi < 2048) ? (float)pi : 8192.f;
        const float inv = powf(10000.f, -(float)i / 32.f);
        const float ang = pos * inv;
        double rev = (double)ang * 0.15915494309189533577; rev -= floor(rev);
        const float fr = (float)rev;
        float2 cs; cs.x = __builtin_amdgcn_cosf(fr); cs.y = __builtin_amdgcn_sinf(fr);
        ((float2*)(ws + WS_ROPE))[e] = cs;
    }
    for (int e = gt; e < 2 * 8 * 128 * 128; e += NGT) {
        const int jj = e & 127, i = (e >> 7) & 127; const float w = (jj <= i) ? AIN(a, I_WSP)[e] : 0.f;
        ((bf16*)(ws + WS_WSP))[e] = (bf16)f2bf(w);
    }
}

__device__ __forceinline__ void norm_phase(const float* hp, const float* hs, const float* g, bf16* nout, int wid, int lane) {
    const int gw = bidx() * 8 + wid, NGW = gridDim.x * 8;
    f32x4 gv[4];
#pragma unroll
    for (int j = 0; j < 4; ++j) gv[j] = *(const f32x4*)(g + 4 * lane + 256 * j);
    for (int row = gw; row < MT; row += NGW) {
        const float* src = (row < MP) ? hp + (size_t)row * DM : hs + (size_t)(row - MP) * DM;
        f32x4 v[4]; float s = 0.f;
#pragma unroll
        for (int j = 0; j < 4; ++j) { v[j] = *(const f32x4*)(src + 4 * lane + 256 * j); s += (v[j].x * v[j].x + v[j].y * v[j].y) + (v[j].z * v[j].z + v[j].w * v[j].w); }
        const float r = rsqrtf(wave_sum(s) * (1.f / DM) + EPS);
        bf16* dst = nout + (size_t)row * DM;
#pragma unroll
        for (int j = 0; j < 4; ++j) { u32x2 o; o.x = pk2(v[j].x * r * gv[j].x, v[j].y * r * gv[j].y); o.y = pk2(v[j].z * r * gv[j].z, v[j].w * r * gv[j].w); *(u32x2*)(dst + 4 * lane + 256 * j) = o; }
    }
}

__device__ __forceinline__ void post_phase(ArgsK a, int jl, int wid, int lane) {
    unsigned char* ws = AWS(a);
    const bf16* Z = (const bf16*)(ws + WS_Z);
    bf16* Qb = (bf16*)(ws + WS_Q); bf16* Kb = (bf16*)(ws + WS_K); bf16* Vb = (bf16*)(ws + WS_V); bf16* Ub = (bf16*)(ws + WS_U); bf16* VBb = (bf16*)(ws + WS_VB);
    const float2* rope = (const float2*)(ws + WS_ROPE);
    const int gw = bidx() * 8 + wid, NGW = gridDim.x * 8;
    const int hh = lane >> 3, sub = lane & 7;
    f32x4 gqk[2][2];
#pragma unroll
    for (int which = 0; which < 2; ++which) { const float* g = AIN(a, which ? I_KG : I_QG) + jl * 64; gqk[which][0] = *(const f32x4*)(g + sub * 4); gqk[which][1] = *(const f32x4*)(g + 32 + sub * 4); }
    const float* gvb = AIN(a, I_VBG) + jl * 512 + lane * 8; const float* bvb = AIN(a, I_VBB) + jl * 512 + lane * 8;
    const f32x4 ga = *(const f32x4*)gvb, gb = *(const f32x4*)(gvb + 4), ba = *(const f32x4*)bvb, bb4 = *(const f32x4*)(bvb + 4);
    for (int row = gw; row < MT; row += NGW) {
        const bool samp = row >= MP; const int t = row & (SEQ - 1), bb = row >> 11, ns = row - MP;
        const int pidx = samp ? 2048 : t;
        const bf16* z = Z + (size_t)row * ZW;
        u32x2 zlo[2], zhi[2];
#pragma unroll
        for (int which = 0; which < 2; ++which) { const bf16* src = z + which * 512 + hh * 64 + sub * 4; zlo[which] = *(const u32x2*)src; zhi[which] = *(const u32x2*)(src + 32); }
        const u32x4 zv = *(const u32x4*)(z + 1024 + lane * 8), zb = *(const u32x4*)(z + 2048 + lane * 8);
        float cs[4], sn[4];
#pragma unroll
        for (int i = 0; i < 4; ++i) { const float2 c2 = rope[pidx * 32 + sub * 4 + i]; cs[i] = c2.x; sn[i] = c2.y; }
#pragma unroll
        for (int which = 0; which < 2; ++which) {
            const u32x2 lo = zlo[which], hi = zhi[which];
            float x1[4] = {bflo(lo.x), bfhi(lo.x), bflo(lo.y), bfhi(lo.y)}, x2[4] = {bflo(hi.x), bfhi(hi.x), bflo(hi.y), bfhi(hi.y)};
            float ss = 0.f;
#pragma unroll
            for (int i = 0; i < 4; ++i) ss += x1[i] * x1[i] + x2[i] * x2[i];
            ss += __shfl_xor(ss, 1); ss += __shfl_xor(ss, 2); ss += __shfl_xor(ss, 4);
            const float r = rsqrtf(ss * (1.f / 64.f) + EPS);
            const f32x4 g1 = gqk[which][0], g2 = gqk[which][1];
            f32x4 o1, o2;
#pragma unroll
            for (int i = 0; i < 4; ++i) { const float y1 = x1[i] * r * g1[i], y2 = x2[i] * r * g2[i]; o1[i] = y1 * cs[i] - y2 * sn[i]; o2[i] = y2 * cs[i] + y1 * sn[i]; }
            bf16* dst = (which ? Kb : Qb) + (size_t)row * 512 + hh * 64 + sub * 4;
            u32x2 p1, p2; p1.x = pk2(o1[0], o1[1]); p1.y = pk2(o1[2], o1[3]); p2.x = pk2(o2[0], o2[1]); p2.y = pk2(o2[2], o2[3]);
            *(u32x2*)dst = p1; *(u32x2*)(dst + 32) = p2;
            if (which == 1) {
                float* ok = samp ? AOUT(a) + O_AKS + (size_t)(jl * MS + ns) * 512 : AOUT(a) + O_AKP + ((size_t)jl * MP + row) * 512;
                __builtin_nontemporal_store(o1, (f32x4*)(ok + hh * 64 + sub * 4)); __builtin_nontemporal_store(o2, (f32x4*)(ok + hh * 64 + 32 + sub * 4));
            }
        }
        {
            const u32x4 vv = zv;
            float* ov = samp ? AOUT(a) + O_AVS + (size_t)(jl * MS + ns) * 512 : AOUT(a) + O_AVP + ((size_t)jl * MP + row) * 512;
            __builtin_nontemporal_store((f32x4){bflo(vv.x), bfhi(vv.x), bflo(vv.y), bfhi(vv.y)}, (f32x4*)(ov + lane * 8));
            __builtin_nontemporal_store((f32x4){bflo(vv.z), bfhi(vv.z), bflo(vv.w), bfhi(vv.w)}, (f32x4*)(ov + lane * 8 + 4));
        }
        {
            const u32x4 bv = zb;
            float x[8] = {gelu_tanh(bflo(bv.x)), gelu_tanh(bfhi(bv.x)), gelu_tanh(bflo(bv.y)), gelu_tanh(bfhi(bv.y)), gelu_tanh(bflo(bv.z)), gelu_tanh(bfhi(bv.z)), gelu_tanh(bflo(bv.w)), gelu_tanh(bfhi(bv.w))};
            float s = 0.f;
#pragma unroll
            for (int i = 0; i < 8; ++i) s += x[i];
            const float mean = wave_sum(s) * (1.f / 512.f); float q = 0.f;
#pragma unroll
            for (int i = 0; i < 8; ++i) { x[i] -= mean; q += x[i] * x[i]; }
            const float rstd = rsqrtf(wave_sum(q) * (1.f / 512.f) + EPS);

            f32x4 ya, yb;
#pragma unroll
            for (int i = 0; i < 4; ++i) { ya[i] = x[i] * rstd * ga[i] + ba[i]; yb[i] = x[4 + i] * rstd * gb[i] + bb4[i]; }
            u32x4 o; o.x = pk2(ya[0], ya[1]); o.y = pk2(ya[2], ya[3]); o.z = pk2(yb[0], yb[1]); o.w = pk2(yb[2], yb[3]);
            *(u32x4*)(VBb + (size_t)row * 512 + lane * 8) = o;
            float* ob = nullptr;
            if (samp) ob = AOUT(a) + O_BVS + (size_t)(jl * MS + ns) * 512;
            else if (t >= 1920) ob = AOUT(a) + O_BVP + ((size_t)(jl * NB + bb) * 128 + (t - 1920)) * 512;
            if (ob) { *(f32x4*)(ob + lane * 8) = ya; *(f32x4*)(ob + lane * 8 + 4) = yb; }
        }
    }
}

__device__ __forceinline__ void combine_phase(ArgsK a, int wid, int lane) {
    unsigned char* ws = AWS(a);
    const bf16* OP = (const bf16*)(ws + WS_OP); const float* LP = (const float*)(ws + WS_LP); bf16* CAT = (bf16*)(ws + WS_CAT);
    const int gw = bidx() * 8 + wid, NGW = gridDim.x * 8; const int hh = lane >> 3;
    for (int row = gw; row < MP; row += NGW) {
        const u32x4 p0 = *(const u32x4*)(OP + ((size_t)0 * MPAD + row) * 512 + lane * 8), p1 = *(const u32x4*)(OP + ((size_t)1 * MPAD + row) * 512 + lane * 8), p2 = *(const u32x4*)(OP + ((size_t)2 * MPAD + row) * 512 + lane * 8);
        const float l0 = LP[((size_t)0 * MPAD + row) * 8 + hh], l1 = LP[((size_t)1 * MPAD + row) * 8 + hh], l2 = LP[((size_t)2 * MPAD + row) * 8 + hh];
        __builtin_amdgcn_sched_barrier(0);
        const float m = fmaxf(l0, fmaxf(l1, l2)); float e0 = __expf(l0 - m), e1 = __expf(l1 - m), e2 = __expf(l2 - m); const float inv = __builtin_amdgcn_rcpf(e0 + e1 + e2);
        e0 *= inv; e1 *= inv; e2 *= inv;
        u32x4 o;
#pragma unroll
        for (int i = 0; i < 4; ++i) { const float lo = e0 * bflo(p0[i]) + e1 * bflo(p1[i]) + e2 * bflo(p2[i]), hi = e0 * bfhi(p0[i]) + e1 * bfhi(p1[i]) + e2 * bfhi(p2[i]); o[i] = pk2(lo, hi); }
        *(u32x4*)(CAT + (size_t)row * DM + lane * 8) = o;
    }
}
struct GemmCfg { int mode; const bf16* A; const bf16* B; int N, K; bf16* O; int ld; const float* xin; const float* xins; float* yout; bf16* hb; bool first, last; const rs_t* rs; rs_t* rsn; };
__device__ __forceinline__ bool gemm_cfg(ArgsK ap, int ph, GemmCfg& c) {
    unsigned char* ws = AWS(ap); float* out = AOUT(ap);
    const int half = ph >= 16 ? 1 : 0, kind = ph - 16 * half, L = 2 * half + (kind >= 9 ? 1 : 0), jl = half;
    c.mode = -1; c.O = nullptr; c.ld = DM; c.A = (const bf16*)(ws + WS_N); c.B = nullptr; c.N = DM; c.K = DM;
    if (kind == 1) { c.mode = 0; c.B = (const bf16*)(ws + WS_WIN) + (size_t)jl * DM * ZW; c.N = ZW; c.O = (bf16*)(ws + WS_Z); c.ld = ZW; }
    else if (kind == 7 || kind == 14) { c.mode = 1; c.B = (const bf16*)(ws + WS_WUP) + (size_t)L * DM * FF; c.N = FF; c.O = (bf16*)(ws + WS_HID); c.ld = FF; }
    else if (kind == 10) { c.mode = 2; c.B = (const bf16*)(ws + WS_WCI) + (size_t)jl * DM * 2048; c.N = 2048; c.O = (bf16*)(ws + WS_X); }
    else if (kind == 5) { c.mode = 3; c.A = (const bf16*)(ws + WS_CAT); c.B = (const bf16*)(ws + WS_WOUT) + (size_t)jl * DM * DM; }
    else if (kind == 12) { c.mode = 3; c.A = (const bf16*)(ws + WS_Y); c.B = (const bf16*)(ws + WS_WCO) + (size_t)jl * DM * DM; }
    else if (kind == 8 || kind == 15) { c.mode = 3; c.A = (const bf16*)(ws + WS_HID); c.B = (const bf16*)(ws + WS_WDN) + (size_t)L * DM * FF; c.K = FF; }
    c.xin = AIN(ap, I_XP); c.xins = AIN(ap, I_XS); c.yout = out; c.hb = (bf16*)(ws + WS_N); c.first = (ph == 5); c.last = (ph == 31);
    rs_t* rsb = (rs_t*)(ws + WS_RS);
    c.rs = rsb + (size_t)(2 * L + ((kind == 7 || kind == 14) ? 1 : 0)) * MPAD; c.rsn = nullptr;
    if (c.mode == 3) { if (kind == 5 || kind == 12) c.rsn = rsb + (size_t)(2 * L + 1) * MPAD; else if (L < 3) c.rsn = rsb + (size_t)(2 * L + 2) * MPAD; }
    return c.mode >= 0;
}
struct EpiAll {
    static constexpr bool PERM = true, AFTER_DRAIN = false;
    ArgsK ap0; int ph;
    __device__ __forceinline__ void operator()(const f32x4 (&acc)[2][2][4][2], const pg8::Unit& u, int wr, int wc, int fr, int fq) const {
        using pg8::pkbf; constexpr int BM = pg8::BM, HALF = pg8::HALF; typedef pg8::bf16_t bf16_t;
        ArgsK ap = (ArgsK)ap0; asm volatile("" : "+s"(ap));
        GemmCfg c; gemm_cfg(ap, ph, c);
        const int mode = c.mode; bf16_t* O = c.O; const int ldc = c.ld; const rs_t* rs = c.rs; rs_t* rsn = c.rsn;
        const int row0 = u.pm * BM + wr * 64 + fr;
        if (mode == 3) {
            const int col0 = u.pn * BM + wc * 32 + 8 * fq; const float* xin = c.xin; float* yout = c.yout; bf16_t* hb = c.hb; const bool first = c.first, last = c.last;
#pragma unroll
            for (int ai = 0; ai < 2; ++ai) {
                f32x4 bb[4][2][2];
                if (first) {
#pragma unroll
                    for (int m = 0; m < 4; ++m)
#pragma unroll
                        for (int bj = 0; bj < 2; ++bj) { const size_t off = (size_t)(row0 + ai * HALF + m * 16) * 1024 + col0 + bj * HALF; bb[m][bj][0] = *(const f32x4*)(xin + off); bb[m][bj][1] = *(const f32x4*)(xin + off + 4); }
                } else {
                    u32x4 wv[4][2];
#pragma unroll
                    for (int m = 0; m < 4; ++m)
#pragma unroll
                        for (int bj = 0; bj < 2; ++bj) wv[m][bj] = *(const u32x4*)(hb + (size_t)(row0 + ai * HALF + m * 16) * 1024 + col0 + bj * HALF);
#pragma unroll
                    for (int m = 0; m < 4; ++m)
#pragma unroll
                        for (int bj = 0; bj < 2; ++bj) { const u32x4 w = wv[m][bj];
                            bb[m][bj][0] = (f32x4){__uint_as_float(w.x << 16), __uint_as_float(w.x & 0xffff0000u), __uint_as_float(w.y << 16), __uint_as_float(w.y & 0xffff0000u)};
                            bb[m][bj][1] = (f32x4){__uint_as_float(w.z << 16), __uint_as_float(w.z & 0xffff0000u), __uint_as_float(w.w << 16), __uint_as_float(w.w & 0xffff0000u)}; }
                }
#pragma unroll
                for (int m = 0; m < 4; ++m) { const int row = row0 + ai * HALF + m * 16; const size_t off = (size_t)row * 1024 + col0; float ss = 0.f;
#pragma unroll
                    for (int bj = 0; bj < 2; ++bj) {
                        const f32x4 h0 = bb[m][bj][0] + acc[ai][bj][m][0], h1 = bb[m][bj][1] + acc[ai][bj][m][1];
                        if (last) { *(f32x4*)(yout + off + bj * HALF) = h0; *(f32x4*)(yout + off + bj * HALF + 4) = h1; }
                        else { u32x4 w; w.x = pkbf(h0[0], h0[1]); w.y = pkbf(h0[2], h0[3]); w.z = pkbf(h1[0], h1[1]); w.w = pkbf(h1[2], h1[3]); *(u32x4*)(hb + off + bj * HALF) = w; }
                        ss += (h0[0] * h0[0] + h0[1] * h0[1]) + (h0[2] * h0[2] + h0[3] * h0[3]) + (h1[0] * h1[0] + h1[1] * h1[1]) + (h1[2] * h1[2] + h1[3] * h1[3]); }
                    if (rsn) { ss += __shfl_xor(ss, 16); ss += __shfl_xor(ss, 32); if (fq == 0) atomicAdd(rsn + row, rs_enc(ss)); } }
            }
        } else if (mode == 2) {
            const int col0 = u.pn * HALF + wc * 32 + 8 * fq;
            rs_t rv[2][4];
#pragma unroll
            for (int ai = 0; ai < 2; ++ai)
#pragma unroll
                for (int m = 0; m < 4; ++m) rv[ai][m] = rs[row0 + ai * HALF + m * 16];
            __builtin_amdgcn_sched_barrier(0);
#pragma unroll
            for (int ai = 0; ai < 2; ++ai)
#pragma unroll
                for (int m = 0; m < 4; ++m) { const int row = row0 + ai * HALF + m * 16; bf16_t* rowp = O + (size_t)row * ldc + col0;
                    const float sc = rs_scale(rv[ai][m]);
                    f32x4 x0, x1;
#pragma unroll
                    for (int e = 0; e < 4; ++e) { x0[e] = sc * acc[ai][0][m][0][e] * __builtin_amdgcn_rcpf(1.f + __expf(-sc * acc[ai][1][m][0][e])); x1[e] = sc * acc[ai][0][m][1][e] * __builtin_amdgcn_rcpf(1.f + __expf(-sc * acc[ai][1][m][1][e])); }
                    u32x4 w; w.x = pkbf(x0[0], x0[1]); w.y = pkbf(x0[2], x0[3]); w.z = pkbf(x1[0], x1[1]); w.w = pkbf(x1[2], x1[3]);
                    *(u32x4*)rowp = w; }
        } else {
            const int col0 = u.pn * BM + wc * 32 + 8 * fq;
            rs_t rv[2][4];
#pragma unroll
            for (int ai = 0; ai < 2; ++ai)
#pragma unroll
                for (int m = 0; m < 4; ++m) rv[ai][m] = rs[row0 + ai * HALF + m * 16];
            __builtin_amdgcn_sched_barrier(0);
#pragma unroll
            for (int ai = 0; ai < 2; ++ai)
#pragma unroll
                for (int m = 0; m < 4; ++m) { const int row = row0 + ai * HALF + m * 16; bf16_t* rowp = O + (size_t)row * ldc + col0;
                    const float sc = rs_scale(rv[ai][m]);
#pragma unroll
                    for (int bj = 0; bj < 2; ++bj) { f32x4 v0 = acc[ai][bj][m][0] * sc, v1 = acc[ai][bj][m][1] * sc;
                        if (mode == 1) {
#pragma unroll
                            for (int e = 0; e < 4; ++e) { const float a = fmaxf(v0[e], 0.f), b = fmaxf(v1[e], 0.f); v0[e] = a * a; v1[e] = b * b; } }
                        u32x4 w; w.x = pkbf(v0[0], v0[1]); w.y = pkbf(v0[2], v0[3]); w.z = pkbf(v1[0], v1[1]); w.w = pkbf(v1[2], v1[3]);
                        *(u32x4*)(rowp + bj * HALF) = w; } }
        }
    }
};
#define XB_TMO      128
#define XB_XCNT(j)  (256  + 64 * (j))
#define XB_XSUB(j)  (1280 + 64 * (j))
#define XB_XGEN(j)  (2304 + 64 * (j))
#define XB_TOP      3328
#define XB_TOPGEN   3392
#define XCD_BAR_WORDS 3456
#define XB_SPIN_CAP (1u << 18)

__device__ __forceinline__ unsigned xb_ld(unsigned* p)              { return __hip_atomic_load(p, __ATOMIC_RELAXED, __HIP_MEMORY_SCOPE_AGENT); }
__device__ __forceinline__ unsigned xb_add(unsigned* p, unsigned v) { return __hip_atomic_fetch_add(p, v, __ATOMIC_RELAXED, __HIP_MEMORY_SCOPE_AGENT); }
__device__ __forceinline__ unsigned xb_xcc_id() { return (unsigned)__builtin_amdgcn_s_getreg((3 << 11) | 20) & 0xFu; }
#define XB_SPIN(cond, bar) do { unsigned _sp = 0; while (cond) { __builtin_amdgcn_s_sleep(1); \
    if ((++_sp & 255u) == 0u) { if (xb_ld(&(bar)[XB_TMO])) break; if (_sp > XB_SPIN_CAP) { atomicAdd(&(bar)[XB_TMO], 1u); break; } } } } while (0)

struct XcdBarrier {
    unsigned* bar; unsigned x;
    volatile LAS unsigned* st;
};

__device__ __forceinline__ XcdBarrier xcd_barrier_post(unsigned* bar, volatile LAS unsigned* st) {
    XcdBarrier b; b.bar = bar; b.x = xb_xcc_id(); b.st = st;
    if (threadIdx.x == 0) (void)xb_add(&bar[XB_XCNT(b.x)], 1u);
    return b;
}
__device__ __forceinline__ void xcd_barrier_complete(unsigned* bar, unsigned x, unsigned& nloc, unsigned& nx) {
    const unsigned G = gridDim.x * gridDim.y * gridDim.z;
    unsigned sum, cnt, mine, sp = 0u;
    for (;;) {
        sum = 0u; cnt = 0u; mine = 0u;
#pragma unroll
        for (unsigned j = 0; j < 16; ++j) { const unsigned c = xb_ld(&bar[XB_XCNT(j)]); sum += c; cnt += (c > 0u) ? 1u : 0u; mine = (j == x) ? c : mine; }
        if (sum == G) break;
        __builtin_amdgcn_s_sleep(1);
        if ((++sp & 255u) == 0u) { if (xb_ld(&bar[XB_TMO])) break; if (sp > XB_SPIN_CAP) { atomicAdd(&bar[XB_TMO], 1u); break; } }
    }
    nloc = mine > 0u ? mine : 1u; nx = cnt > 0u ? cnt : 1u;
}

__device__ __forceinline__ void xcd_barrier(const XcdBarrier& b) {
    asm volatile("s_waitcnt vmcnt(0)" ::: "memory");
    __syncthreads();
    if (threadIdx.x == 0) {
        unsigned* bar = b.bar;
        __builtin_amdgcn_s_waitcnt(0);
        unsigned nloc = b.st[0], nx = b.st[1];
        if (nloc == 0u) { xcd_barrier_complete(bar, b.x, nloc, nx); b.st[0] = nloc; b.st[1] = nx; }
        const unsigned old = xb_add(&bar[XB_XSUB(b.x)], 1u);
        const unsigned gen = old / nloc;
        if (old + 1u == (gen + 1u) * nloc) {
            __builtin_amdgcn_fence(__ATOMIC_RELEASE, "agent");
            asm volatile("s_waitcnt vmcnt(0)" ::: "memory");
            const unsigned og = xb_add(&bar[XB_TOP], 1u);
            const unsigned tg = og / nx;
            if (og + 1u == (tg + 1u) * nx) xb_add(&bar[XB_TOPGEN], 1u);
            else XB_SPIN(xb_ld(&bar[XB_TOPGEN]) == tg, bar);
            __builtin_amdgcn_fence(__ATOMIC_ACQUIRE, "agent");
            xb_add(&bar[XB_XGEN(b.x)], 1u);
            asm volatile("s_waitcnt vmcnt(0)" ::: "memory");
        } else {
            XB_SPIN(xb_ld(&bar[XB_XGEN(b.x)]) == gen, bar);
            __builtin_amdgcn_fence(__ATOMIC_ACQUIRE, "agent");
            asm volatile("s_waitcnt vmcnt(0)" ::: "memory");
        }
    }
    __syncthreads();
}
constexpr int TS = 144;
constexpr int LDS_KT = 0, LDS_VT = 256 * TS;
__device__ __forceinline__ s16x4 tr_read(LAS unsigned char* p) { return __builtin_bit_cast(s16x4, __builtin_amdgcn_ds_read_tr16_b64_v4i16((LAS s16x4*)p)); }
#define MFMA16(x, y, c) __builtin_amdgcn_mfma_f32_16x16x32_bf16((x), (y), (c), 0, 0, 0)

struct AttnIdx { int br, b, h, dsh, res, qb; size_t rowb; };
__device__ __forceinline__ AttnIdx attn_decode(int unit) {
    AttnIdx x; x.br = unit >> 10; const int rem = unit & 1023, bh = rem >> 4, idx = rem & 15; x.b = bh >> 3; x.h = bh & 7;
    x.dsh = 2 * x.br; const int nbm = (16 >> x.dsh) - 1; x.res = idx >> (4 - x.dsh); x.qb = idx & nbm; x.rowb = (size_t)x.b * SEQ + x.res; return x;
}
__device__ __forceinline__ void attn_load(ArgsK a, int unit, int tid, u32x4 (&kv)[4], u32x4 (&vv)[4]) {
    const bf16* Kb = (const bf16*)(AWS(a) + WS_K); const bf16* Zv = (const bf16*)(AWS(a) + WS_Z) + 1024;
    const AttnIdx x = attn_decode(unit);
#pragma unroll
    for (int it = 0; it < 4; ++it) {
        const int c = tid + 512 * it, kr = c >> 3, ch = c & 7, s0 = 128 * (x.qb - 1) + kr, s = s0 < 0 ? 0 : s0;
        const size_t row = x.rowb + ((size_t)s << x.dsh); kv[it] = *(const u32x4*)(Kb + row * 512 + x.h * 64 + ch * 8); vv[it] = *(const u32x4*)(Zv + row * ZW + x.h * 64 + ch * 8);
    }
}
__device__ __forceinline__ void attn_stage(LAS unsigned char* lds, int tid, const u32x4 (&kv)[4], const u32x4 (&vv)[4]) {
#pragma unroll
    for (int it = 0; it < 4; ++it) { const int c = tid + 512 * it, kr = c >> 3, ch = c & 7;
        *(LAS u32x4*)(lds + LDS_KT + kr * TS + ch * 16) = kv[it]; *(LAS u32x4*)(lds + LDS_VT + kr * TS + ch * 16) = vv[it]; }
}
__device__ __forceinline__ void attn_loadq(ArgsK a, int unit, int wid, int lane, bf16x8& qf0, bf16x8& qf1) {
    const bf16* Qb = (const bf16*)(AWS(a) + WS_Q); const int fr = lane & 15, fq = lane >> 4;
    const AttnIdx x = attn_decode(unit); const int sq = 128 * x.qb + 16 * wid + fr; const size_t rowq = x.rowb + ((size_t)sq << x.dsh);
    qf0 = *(const bf16x8*)(Qb + rowq * 512 + x.h * 64 + fq * 8); qf1 = *(const bf16x8*)(Qb + rowq * 512 + x.h * 64 + 32 + fq * 8);
}
__device__ __forceinline__ void attn_compute(ArgsK a, LAS unsigned char* lds, int unit, int wid, int lane, const bf16x8 qf0, const bf16x8 qf1) {
    unsigned char* ws = AWS(a);
    bf16* OP = (bf16*)(ws + WS_OP); float* LP = (float*)(ws + WS_LP);
    const int fr = lane & 15, fq = lane >> 4;
    const AttnIdx x = attn_decode(unit); const int br = x.br, h = x.h, qb = x.qb, dsh = x.dsh;
    const int sq = 128 * qb + 16 * wid + fr; const size_t rowq = x.rowb + ((size_t)sq << dsh);
    f32x4 S[10];
#pragma unroll
    for (int kp = 0; kp < 9; ++kp) {
        const int kt = wid + kp; LAS unsigned char* ka = lds + LDS_KT + (16 * kt + fr) * TS + fq * 16;
        const bf16x8 x0 = *(const LAS bf16x8*)ka, x1 = *(const LAS bf16x8*)(ka + 64);
        f32x4 acc = {0.f, 0.f, 0.f, 0.f};
        acc = MFMA16(x0, qf0, acc); acc = MFMA16(x1, qf1, acc); S[kp] = acc;
    }
    constexpr float C2 = 0.125f * 1.4426950408889634f;
    float mx = -INFINITY;
#pragma unroll
    for (int kp = 0; kp < 9; ++kp) {
        const bool dead = (qb == 0) && (wid + kp < 8);
#pragma unroll
        for (int v = 0; v < 4; ++v) {
            bool ok = !dead;
            if (kp == 0) ok = ok && (fr <= 4 * fq + v);
            if (kp == 8) ok = ok && (fr >= 4 * fq + v);
            const float sc = ok ? S[kp][v] * C2 : -INFINITY; S[kp][v] = sc; mx = fmaxf(mx, sc);
        }
    }
    mx = fmaxf(mx, __shfl_xor(mx, 16)); mx = fmaxf(mx, __shfl_xor(mx, 32));
    float den = 0.f;
#pragma unroll
    for (int kp = 0; kp < 9; ++kp)
#pragma unroll
        for (int v = 0; v < 4; ++v) { const float p = __builtin_amdgcn_exp2f(S[kp][v] - mx); S[kp][v] = p; den += p; }
    den += __shfl_xor(den, 16); den += __shfl_xor(den, 32);
    S[9] = (f32x4){0.f, 0.f, 0.f, 0.f};
    f32x4 O[4];
#pragma unroll
    for (int dt = 0; dt < 4; ++dt) O[dt] = (f32x4){0.f, 0.f, 0.f, 0.f};
#pragma unroll
    for (int j = 0; j < 5; ++j) {
        u32x4 pw; pw.x = pk2(S[2 * j][0], S[2 * j][1]); pw.y = pk2(S[2 * j][2], S[2 * j][3]); pw.z = pk2(S[2 * j + 1][0], S[2 * j + 1][1]); pw.w = pk2(S[2 * j + 1][2], S[2 * j + 1][3]);
        const bf16x8 pf = __builtin_bit_cast(bf16x8, pw);
        const int kta = wid + 2 * j; int ktb = kta + 1; ktb = ktb > 15 ? 15 : ktb;
        LAS unsigned char* va = lds + LDS_VT + (16 * kta + 4 * fq + (fr >> 2)) * TS + (fr & 3) * 8;
        LAS unsigned char* vb = lds + LDS_VT + (16 * ktb + 4 * fq + (fr >> 2)) * TS + (fr & 3) * 8;
#pragma unroll
        for (int dt = 0; dt < 4; ++dt) {
            const s16x4 xa = tr_read(va + dt * 32), xb = tr_read(vb + dt * 32);
            const bf16x8 xf = __builtin_shufflevector(xa, xb, 0, 1, 2, 3, 4, 5, 6, 7);
            O[dt] = MFMA16(xf, pf, O[dt]);
        }
    }
    const float rden = __builtin_amdgcn_rcpf(den);
    bf16* op = OP + ((size_t)br * MPAD + rowq) * 512 + h * 64 + 4 * fq;
#pragma unroll
    for (int dt = 0; dt < 4; ++dt) { u32x2 o; o.x = pk2(O[dt][0] * rden, O[dt][1] * rden); o.y = pk2(O[dt][2] * rden, O[dt][3] * rden); *(u32x2*)(op + 16 * dt) = o; }
    if (fq == 0) LP[((size_t)br * MPAD + rowq) * 8 + h] = mx * 0.6931471805599453f + __logf(den);
}

__device__ __forceinline__ void spatial_unit(ArgsK a, LAS unsigned char* lds, int unit, int jl, int tid, int wid, int lane) {
    unsigned char* ws = AWS(a);
    const bf16* VBb = (const bf16*)(ws + WS_VB); const bf16* Zu = (const bf16*)(ws + WS_Z) + 1536; const bf16* WSP = (const bf16*)(ws + WS_WSP); bf16* CAT = (bf16*)(ws + WS_CAT);
    const int fr = lane & 15, fq = lane >> 4;
    const int b = unit >> 7, c = (unit >> 3) & 15, g = unit & 7;
    const size_t r0 = (size_t)b * SEQ + c * 128;
    { u32x4 sv[2];
#pragma unroll
      for (int it = 0; it < 2; ++it) { const int cc = tid + 512 * it, kr = cc >> 3, ch = cc & 7; sv[it] = *(const u32x4*)(VBb + (r0 + kr) * 512 + g * 64 + ch * 8); }
#pragma unroll
      for (int it = 0; it < 2; ++it) { const int cc = tid + 512 * it, kr = cc >> 3, ch = cc & 7; *(LAS u32x4*)(lds + LDS_VT + kr * TS + ch * 16) = sv[it]; } }
    __syncthreads();
    const int i = 16 * wid + fr;
    const bf16* wrow = WSP + ((size_t)(jl * 8 + g) * 128 + i) * 128;
    f32x4 O[4];
#pragma unroll
    for (int dt = 0; dt < 4; ++dt) O[dt] = (f32x4){0.f, 0.f, 0.f, 0.f};
    const int nks = (wid >> 1) + 1;
    for (int js = 0; js < nks; ++js) {
        const u32x2 wa = *(const u32x2*)(wrow + 32 * js + 4 * fq), wb = *(const u32x2*)(wrow + 32 * js + 16 + 4 * fq);
        u32x4 pw; pw.x = wa.x; pw.y = wa.y; pw.z = wb.x; pw.w = wb.y;
        const bf16x8 pf = __builtin_bit_cast(bf16x8, pw);
        LAS unsigned char* va = lds + LDS_VT + (32 * js + 4 * fq + (fr >> 2)) * TS + (fr & 3) * 8;
        LAS unsigned char* vb = va + 16 * TS;
#pragma unroll
        for (int dt = 0; dt < 4; ++dt) {
            const s16x4 xa = tr_read(va + dt * 32), xb = tr_read(vb + dt * 32);
            const bf16x8 xf = __builtin_shufflevector(xa, xb, 0, 1, 2, 3, 4, 5, 6, 7);
            O[dt] = MFMA16(xf, pf, O[dt]);
        }
    }
    const float bs = AIN(a, I_BSP)[(jl * 8 + g) * 128 + i];
    const bf16* up = Zu + (r0 + i) * ZW + g * 64 + 4 * fq; bf16* cp = CAT + (r0 + i) * DM + 512 + g * 64 + 4 * fq;
    u32x2 uq[4];
#pragma unroll
    for (int dt = 0; dt < 4; ++dt) uq[dt] = *(const u32x2*)(up + 16 * dt);
#pragma unroll
    for (int dt = 0; dt < 4; ++dt) {
        const u32x2 uu = uq[dt];
        u32x2 o; o.x = pk2(gelu_tanh(bflo(uu.x)) * (O[dt][0] + bs), gelu_tanh(bfhi(uu.x)) * (O[dt][1] + bs)); o.y = pk2(gelu_tanh(bflo(uu.y)) * (O[dt][2] + bs), gelu_tanh(bfhi(uu.y)) * (O[dt][3] + bs));
        *(u32x2*)(cp + 16 * dt) = o;
    }
}

__device__ __forceinline__ void sample_task(ArgsK a, LAS unsigned char* lds, int task, int jl, int tid, int wid, int lane) {
    unsigned char* ws = AWS(a);
    const bf16* Qb = (const bf16*)(ws + WS_Q); const bf16* Kb = (const bf16*)(ws + WS_K); const bf16* Zv = (const bf16*)(ws + WS_Z) + 1024; bf16* CAT = (bf16*)(ws + WS_CAT);
    const int n = task >> 3, h = task & 7; const size_t row = (size_t)MP + n;
    LAS float* qs = (LAS float*)(lds + 256 * wid);
    LAS float* part = (LAS float*)(lds + 4096);
    LAS float* fin = (LAS float*)(lds + 4096 + 8 * 3 * 68 * 4);
    const float qd = bflo((unsigned)Qb[row * 512 + h * 64 + lane]);
    qs[lane] = qd;
    const float* ck = AIN(a, I_CK) + ((size_t)(jl * MS + n) * 2048) * 512 + h * 64;
    const float* cv = AIN(a, I_CV) + ((size_t)(jl * MS + n) * 2048) * 512 + h * 64;
    const int br = (lane >> 4) > 2 ? 2 : (lane >> 4), el = lane & 15, dsh = 2 * br;
    const bool live = lane < 48;
    const int e = 16 * wid + el;
    const float* kr = ck + (size_t)(2048 - ((e + 1) << dsh)) * 512;
    float s = 0.f;
    { f32x4 kq[16];
#pragma unroll
      for (int c = 0; c < 16; ++c) kq[c] = *(const f32x4*)(kr + 4 * c);
#pragma unroll
      for (int c = 0; c < 16; ++c) { const f32x4 kv = kq[c]; const f32x4 qv = *(const LAS f32x4*)(qs + 4 * c); s += (kv.x * qv.x + kv.y * qv.y) + (kv.z * qv.z + kv.w * qv.w); } }
    s = live ? s * 0.125f : -INFINITY;
    float m = s;
#pragma unroll
    for (int o = 1; o < 16; o <<= 1) m = fmaxf(m, __shfl_xor(m, o));
    const float p = live ? __expf(s - m) : 0.f;
    float l = p;
#pragma unroll
    for (int o = 1; o < 16; o <<= 1) l += __shfl_xor(l, o);
    f32x4 o4 = {0.f, 0.f, 0.f, 0.f};
#pragma unroll
    for (int j = 0; j < 16; ++j) {
        const float pj = __shfl(p, (lane & 48) + j);
        const f32x4 v4 = *(const f32x4*)(cv + (size_t)(2048 - ((16 * wid + j + 1) << dsh)) * 512 + 4 * el);
        o4 += pj * v4;
    }
    if (live) { LAS float* pp = part + (wid * 3 + br) * 68; if (el == 0) { pp[0] = m; pp[1] = l; } *(LAS f32x4*)(pp + 4 + 4 * el) = o4; }
    __syncthreads();
    if (wid < 3) {
        const float kd = bflo((unsigned)Kb[row * 512 + h * 64 + lane]), vd = bflo((unsigned)Zv[row * ZW + h * 64 + lane]);
        const float s_new = wave_sum(qd * kd) * 0.125f;
        float M = s_new;
#pragma unroll
        for (int w = 0; w < 8; ++w) M = fmaxf(M, part[(w * 3 + wid) * 68]);
        float L = __expf(s_new - M), O = L * vd;
#pragma unroll
        for (int w = 0; w < 8; ++w) { const LAS float* pp = part + (w * 3 + wid) * 68; const float f = __expf(pp[0] - M); L += pp[1] * f; O += pp[4 + lane] * f; }
        LAS float* ff = fin + wid * 68; if (lane == 0) ff[0] = M + __logf(L); ff[4 + lane] = O / L;
    }
    __syncthreads();
    if (wid == 0) {
        const float l0 = fin[0], l1 = fin[68], l2 = fin[136]; const float mm = fmaxf(l0, fmaxf(l1, l2));
        const float e0 = __expf(l0 - mm), e1 = __expf(l1 - mm), e2 = __expf(l2 - mm);
        const float att = (e0 * fin[4 + lane] + e1 * fin[68 + 4 + lane] + e2 * fin[136 + 4 + lane]) / (e0 + e1 + e2);
        CAT[row * DM + h * 64 + lane] = (bf16)f2bf(att);
    }
}
__device__ __forceinline__ void sample_gate(ArgsK a, int jl, int gt, int ngt) {
    unsigned char* ws = AWS(a);
    const bf16* VBb = (const bf16*)(ws + WS_VB); const bf16* Zu = (const bf16*)(ws + WS_Z) + 1536; bf16* CAT = (bf16*)(ws + WS_CAT);
    for (int e = gt; e < MS * 512; e += ngt) {
        const int n = e >> 9, c = e & 511, g = c >> 6; const size_t row = (size_t)MP + n;
        const float w00 = AIN(a, I_WSP)[(size_t)(jl * 8 + g) * 128 * 128], b0 = AIN(a, I_BSP)[(jl * 8 + g) * 128];
        const float u = gelu_tanh(bflo((unsigned)Zu[row * ZW + c])), vb = bflo((unsigned)VBb[row * 512 + c]);
        CAT[row * DM + 512 + c] = (bf16)f2bf(u * (w00 * vb + b0));
    }
}

__device__ __forceinline__ float bfly32(const float (&v)[32], int lane) {
    float r16[16], r8[8], r4[4], r2[2];
    { const bool hi = lane & 32;
#pragma unroll
      for (int i = 0; i < 16; ++i) { const float keep = hi ? v[i + 16] : v[i], send = hi ? v[i] : v[i + 16]; r16[i] = keep + __shfl_xor(send, 32); } }
    { const bool hi = lane & 16;
#pragma unroll
      for (int i = 0; i < 8; ++i) { const float keep = hi ? r16[i + 8] : r16[i], send = hi ? r16[i] : r16[i + 8]; r8[i] = keep + __shfl_xor(send, 16); } }
    { const bool hi = lane & 8;
#pragma unroll
      for (int i = 0; i < 4; ++i) { const float keep = hi ? r8[i + 4] : r8[i], send = hi ? r8[i] : r8[i + 4]; r4[i] = keep + __shfl_xor(send, 8); } }
    { const bool hi = lane & 4;
#pragma unroll
      for (int i = 0; i < 2; ++i) { const float keep = hi ? r4[i + 2] : r4[i], send = hi ? r4[i] : r4[i + 2]; r2[i] = keep + __shfl_xor(send, 4); } }
    float r1; { const bool hi = lane & 2; const float keep = hi ? r2[1] : r2[0], send = hi ? r2[0] : r2[1]; r1 = keep + __shfl_xor(send, 2); }
    return r1 + __shfl_xor(r1, 1);
}
__device__ __forceinline__ void conv_phase(ArgsK a, LAS unsigned char* lds, int jl, int tid, int wid, int lane) {
    unsigned char* ws = AWS(a);
    const bf16* X = (const bf16*)(ws + WS_X); bf16* Y = (bf16*)(ws + WS_Y); const float* ZS = (const float*)(ws + WS_ZS);
    const int c0 = 2 * tid;
    float w0[31], w1[31];
#pragma unroll
    for (int w = 0; w < 31; ++w) { const float2 t = *(const float2*)(AIN(a, I_WDW) + (size_t)(jl * 31 + w) * DM + c0); w0[w] = t.x; w1[w] = t.y; }
    const float2 bd = *(const float2*)(AIN(a, I_BDW) + jl * DM + c0), gg = *(const float2*)(AIN(a, I_CG) + jl * DM + c0), be = *(const float2*)(AIN(a, I_CB) + jl * DM + c0);
    LAS float* red = (LAS float*)lds;
    LAS float* tot = (LAS float*)(lds + 2048);
    constexpr int CT = 32, NU = MP / CT;
    for (int unit = bidx(); unit < NU + MS; unit += gridDim.x) {
        if (unit < NU) {
            const int b = unit >> 6, t0 = (unit & 63) * CT; const bool lastu = (unit & 63) == 63;
            unsigned xu[CT + 30];
#pragma unroll
            for (int r = 0; r < CT + 30; ++r) { const int t = t0 - 30 + r, tc = t < 0 ? 0 : t; xu[r] = *(const unsigned*)(X + ((size_t)b * SEQ + tc) * DM + c0); }
            if (lastu) {
#pragma unroll
                for (int r = CT; r < CT + 30; ++r) { float2 o; o.x = bflo(xu[r]); o.y = bfhi(xu[r]); *(float2*)(AOUT(a) + O_CCP + ((size_t)(jl * NB + b) * 30 + (r - CT)) * DM + c0) = o; }
            }
#pragma unroll
            for (int hf = 0; hf < 2; ++hf) {
                float a0[16], a1[16];
#pragma unroll
                for (int tt = 0; tt < 16; ++tt) { a0[tt] = bd.x; a1[tt] = bd.y; }
#pragma unroll
                for (int rr = 0; rr < 46; ++rr) {
                    const int r = 16 * hf + rr, t = t0 - 30 + r;
                    const float x0 = t >= 0 ? bflo(xu[r]) : 0.f, x1 = t >= 0 ? bfhi(xu[r]) : 0.f;
#pragma unroll
                    for (int tt = 0; tt < 16; ++tt) { const int w = rr - tt; if (w >= 0 && w <= 30) { a0[tt] += x0 * w0[w]; a1[tt] += x1 * w1[w]; } }
                }
                {
                    float sv[32];
#pragma unroll
                    for (int tt = 0; tt < 16; ++tt) { sv[tt] = a0[tt] + a1[tt]; sv[16 + tt] = a0[tt] * a0[tt] + a1[tt] * a1[tt]; }
                    const float wt = bfly32(sv, lane);
                    if ((lane & 1) == 0) red[wid * 64 + (lane >> 1)] = wt;
                }
                __syncthreads();
                if (tid < 64) { float s = 0.f;
#pragma unroll
                    for (int w = 0; w < 8; ++w) s += red[w * 64 + tid];
                    tot[tid] = s; }
                __syncthreads();
#pragma unroll
                for (int tt = 0; tt < 16; ++tt) {
                    const float mean = tot[tt] * (1.f / DM), var = fmaxf(tot[tt + 16] * (1.f / DM) - mean * mean, 0.f), rstd = rsqrtf(var + EPS);
                    const float y0 = (a0[tt] - mean) * rstd * gg.x + be.x, y1 = (a1[tt] - mean) * rstd * gg.y + be.y;
                    const float z0 = y0 * __builtin_amdgcn_rcpf(1.f + __expf(-y0)), z1 = y1 * __builtin_amdgcn_rcpf(1.f + __expf(-y1));
                    *(unsigned*)(Y + ((size_t)b * SEQ + t0 + 16 * hf + tt) * DM + c0) = pk2(z0, z1);
                }
                __syncthreads();
            }
        } else {
            const int n = unit - NU;
            const int np = 256 * (c0 >> 7) + (c0 & 127);
            const float2 av = *(const float2*)(ZS + (size_t)n * 2048 + np), gv = *(const float2*)(ZS + (size_t)n * 2048 + np + 128);
            const float xn0 = av.x / (1.f + __expf(-gv.x)), xn1 = av.y / (1.f + __expf(-gv.y));
            float s0 = bd.x + xn0 * w0[30], s1 = bd.y + xn1 * w1[30];
            const float* st = AIN(a, I_CST) + ((size_t)(jl * MS + n) * 30) * DM + c0;
            float* oc = AOUT(a) + O_CCS + ((size_t)(jl * MS + n) * 30) * DM + c0;
            float2 sst[30];
#pragma unroll
            for (int w = 0; w < 30; ++w) sst[w] = *(const float2*)(st + (size_t)w * DM);
#pragma unroll
            for (int w = 0; w < 30; ++w) { const float2 sv = sst[w]; s0 += sv.x * w0[w]; s1 += sv.y * w1[w]; if (w >= 1) *(float2*)(oc + (size_t)(w - 1) * DM) = sv; }
            { float2 o; o.x = xn0; o.y = xn1; *(float2*)(oc + (size_t)29 * DM) = o; }
            const float s = wave_sum(s0 + s1), q = wave_sum(s0 * s0 + s1 * s1);
            if (lane == 0) { red[wid * 64] = s; red[wid * 64 + 16] = q; }
            __syncthreads();
            if (tid < 64) { float t = 0.f;
#pragma unroll
                for (int w = 0; w < 8; ++w) t += red[w * 64 + tid];
                tot[tid] = t; }
            __syncthreads();
            const float mean = tot[0] * (1.f / DM), var = fmaxf(tot[16] * (1.f / DM) - mean * mean, 0.f), rstd = rsqrtf(var + EPS);
            const float y0 = (s0 - mean) * rstd * gg.x + be.x, y1 = (s1 - mean) * rstd * gg.y + be.y;
            *(unsigned*)(Y + ((size_t)MP + n) * DM + c0) = pk2(y0 / (1.f + __expf(-y0)), y1 / (1.f + __expf(-y1)));
            __syncthreads();
        }
    }
}

template <class F> __device__ __forceinline__ void skinny_gemm(LAS unsigned char* lds, const bf16* A, const bf16* Bt, int N, int K, int tid, int wid, int lane, F f) {
    const int fr = lane & 15, fq = lane >> 4; LAS float* red = (LAS float*)lds;
    const int ks = K >> 3;
    for (int cgp = bidx(); cgp < (N >> 4); cgp += gridDim.x) {
        f32x4 acc0 = {0.f, 0.f, 0.f, 0.f}, acc1 = {0.f, 0.f, 0.f, 0.f};
        const bf16* a0p = A + (size_t)fr * K + wid * ks + fq * 8; const bf16* a1p = a0p + (size_t)16 * K; const bf16* bp = Bt + (size_t)(cgp * 16 + fr) * K + wid * ks + fq * 8;
        for (int kk = 0; kk < ks; kk += 128) {
            bf16x8 x[4], y0[4], y1[4];
#pragma unroll
            for (int q = 0; q < 4; ++q) { x[q] = *(const bf16x8*)(bp + kk + 32 * q); y0[q] = *(const bf16x8*)(a0p + kk + 32 * q); y1[q] = *(const bf16x8*)(a1p + kk + 32 * q); }
            __builtin_amdgcn_sched_barrier(0);
#pragma unroll
            for (int q = 0; q < 4; ++q) { acc0 = MFMA16(x[q], y0[q], acc0); acc1 = MFMA16(x[q], y1[q], acc1); }
        }
#pragma unroll
        for (int v = 0; v < 4; ++v) { red[(wid * 32 + fr) * 16 + 4 * fq + v] = acc0[v]; red[(wid * 32 + 16 + fr) * 16 + 4 * fq + v] = acc1[v]; }
        __syncthreads();
        { const int r = tid >> 4, c = tid & 15; float s = 0.f;
#pragma unroll
          for (int w = 0; w < 8; ++w) s += red[(w * 32 + r) * 16 + c];
          f(r, cgp * 16 + c, s); }
        __syncthreads();
    }
}
#ifndef MK_MULTI
#define MK_MULTI 0
#endif
constexpr int N_PHASES = 32;
#ifndef PH_MASK
#define PH_MASK 0xffff
#endif
#define PHON(k) ((PH_MASK >> (k)) & 1)
#ifndef REPEAT_MASK
#define REPEAT_MASK 0
#endif
__device__ __forceinline__ int fresh_tid(int wid0) { int t = wid0 * 64 + (int)__builtin_amdgcn_mbcnt_hi(~0u, __builtin_amdgcn_mbcnt_lo(~0u, 0u)); asm volatile("" : "+v"(t)); return t; }
__global__ void __launch_bounds__(512, 2) fwd_kernel(Args a_unused) {
    extern __shared__ __attribute__((aligned(16))) unsigned char lds_raw[];
    ArgsK ap0 = (ArgsK)__builtin_amdgcn_kernarg_segment_ptr();
    LAS unsigned char* lds = (LAS unsigned char*)lds_raw;
    cg::grid_group grid = cg::this_grid();
    const int wid0 = __builtin_amdgcn_readfirstlane((int)threadIdx.x >> 6);
    const int ph_lo = ap0->ph_lo, ph_hi = ap0->ph_hi;
    volatile LAS unsigned* bst = (volatile LAS unsigned*)(lds + LDS_BAR_OFF);
    if (threadIdx.x < 2) bst[threadIdx.x] = 0u;
    __syncthreads();
    XcdBarrier xbar; xbar.bar = (unsigned*)(AWS(ap0) + WS_BAR); xbar.x = 0; xbar.st = bst;
    if (ph_hi - ph_lo > 1) xbar = xcd_barrier_post((unsigned*)(AWS(ap0) + WS_BAR), bst);
    if (ph_lo < 0) grid.sync();
    for (int ph = ph_lo; ph < ph_hi; ++ph) {
        const int kind0 = ph - (ph >= 16 ? 16 : 0);
        if (ph != 0 && (kind0 == 0 || kind0 == 6 || kind0 == 9 || kind0 == 13)) continue;
        const int reps = ((REPEAT_MASK >> kind0) & 1) ? 2 : 1;
        for (int rep = 0; rep < reps; ++rep) {
        int phv = ph; asm volatile("" : "+s"(phv));
        const int half = phv >= 16 ? 1 : 0, kind = phv - 16 * half, L = 2 * half + (kind >= 9 ? 1 : 0), jl = half;
        const bool is_gemm = (kind == 1 || kind == 5 || kind == 7 || kind == 8 || kind == 10 || kind == 12 || kind == 14 || kind == 15);
        if (is_gemm) {
            {
                ArgsK ap = ap0; asm volatile("" : "+s"(ap));
                GemmCfg c; gemm_cfg(ap, phv, c);
                EpiAll E{ap0, phv};
                pg8::Gemm g{c.A, c.B, MP, c.N, c.K}; pg8::StaticOrder S; S.init(MP, c.N, (int)gridDim.x, bidx());
                pg8::gemm_phase<EpiAll, pg8::StaticOrder, true, true>(lds, g, S, E, fresh_tid(wid0));
            }
            {
                ArgsK ap = ap0; asm volatile("" : "+s"(ap));
                GemmCfg c; gemm_cfg(ap, phv, c);
                const int gmode = c.mode; bf16* gO = c.O; const int gld = c.ld; const rs_t* rs = c.rs; rs_t* rsn = c.rsn;
                const float* xs = c.xins; float* ys = c.yout + O_YS; bf16* hbs = c.hb + (size_t)MP * DM; const bool first = c.first, last = c.last;
                float* zs = (float*)(AWS(ap) + WS_ZS);
                const int tid = fresh_tid(wid0), wid = __builtin_amdgcn_readfirstlane(tid >> 6), lane = tid & 63;
                skinny_gemm(lds, c.A + (size_t)MP * c.K, c.B, c.N, c.K, tid, wid, lane, [=](int r, int cc, float v) {
                    if (gmode == 3) {
                        const float hv = (first ? xs[r * DM + cc] : bflo((unsigned)hbs[r * DM + cc])) + v;
                        if (last) ys[r * DM + cc] = hv; else hbs[r * DM + cc] = (bf16)f2bf(hv);
                        if (rsn) { float ss = hv * hv; ss += __shfl_xor(ss, 1); ss += __shfl_xor(ss, 2); ss += __shfl_xor(ss, 4); ss += __shfl_xor(ss, 8);
                            if ((cc & 15) == 0) atomicAdd(rsn + MP + r, rs_enc(ss)); }
                    } else {
                        const float sv = v * rs_scale(rs[MP + r]);
                        if (gmode == 2) zs[r * 2048 + cc] = sv;
                        else { const float t = fmaxf(sv, 0.f); gO[(size_t)(MP + r) * gld + cc] = (bf16)f2bf(gmode == 1 ? t * t : sv); }
                    }
                });
            }
            if (phv == 1 || phv == 17) {
                ArgsK ap = ap0; asm volatile("" : "+s"(ap));
                const int G = (int)gridDim.x, nrem = 640 % G, c = bidx();
                const bool all = (nrem == 0); const int nhelp = all ? G : G - nrem, hidx = all ? c : c - nrem;
                if (hidx >= 0) { const int tid = fresh_tid(wid0), wid = __builtin_amdgcn_readfirstlane(tid >> 6), lane = tid & 63; convert_set(ap, phv == 1 ? 1 : 2, hidx * 8 + wid, nhelp * 8, lane); }
            }
        } else {
            ArgsK a = ap0; asm volatile("" : "+s"(a));
            const int tid = fresh_tid(wid0), wid = __builtin_amdgcn_readfirstlane(tid >> 6), lane = tid & 63;
            switch (kind) {
            case 0: case 6: case 9: case 13: if (PHON(0)) {
                if (phv == 0 && rep == 0) { const int npro = ((REPEAT_MASK >> 16) & 1) ? 2 : 1; for (int q = 0; q < npro; ++q) { prologue(a, lds, tid, wid, lane); __syncthreads(); } }
            } break;
            case 2: if (PHON(2)) post_phase(a, jl, wid, lane); break;
            case 3: if (PHON(3)) {
                for (int rq = 0; rq < (((REPEAT_MASK >> 17) & 1) ? 2 : 1); ++rq) {
                    const int G = (int)gridDim.x, c = bidx(); const bool xmap = (G == 256);
                    const int nr = xmap ? 12 : (3072 - c + G - 1) / G;
                    u32x4 kvA[4], vvA[4], kvB[4], vvB[4]; bf16x8 qA0 = {0, 0, 0, 0, 0, 0, 0, 0}, qA1 = qA0, qB0 = qA0, qB1 = qA0;
#pragma unroll
                    for (int i = 0; i < 4; ++i) { kvA[i] = (u32x4){0u, 0u, 0u, 0u}; vvA[i] = kvA[i]; kvB[i] = kvA[i]; vvB[i] = kvA[i]; }
#define ATT_UNIT(r_) (xmap ? ((((r_) * 32 + (c >> 3)) >> 7) * 1024 + (((((((r_) * 32 + (c >> 3)) >> 4) & 7) << 3) + (c & 7)) << 4) + (((r_) * 32 + (c >> 3)) & 15)) : (c + (r_) * G))
                    constexpr int ABUF = 2 * 256 * TS;
                    if (nr > 0) { const int u0 = ATT_UNIT(0); attn_load(a, u0, tid, kvA, vvA); attn_loadq(a, u0, wid, lane, qA0, qA1); }
                    if (nr > 1) { const int u1 = ATT_UNIT(1); attn_load(a, u1, tid, kvB, vvB); attn_loadq(a, u1, wid, lane, qB0, qB1); }
                    __syncthreads();
                    if (nr > 0) attn_stage(lds, tid, kvA, vvA);
                    __syncthreads();
#pragma unroll 1
                    for (int r = 0; r < nr; r += 2) {
                        {
                            const int u = ATT_UNIT(r); const bf16x8 qf0 = qA0, qf1 = qA1;
                            if (r + 1 < nr) attn_stage(lds + ABUF, tid, kvB, vvB);
                            if (r + 2 < nr) { const int un = ATT_UNIT(r + 2); attn_load(a, un, tid, kvA, vvA); attn_loadq(a, un, wid, lane, qA0, qA1); }
                            attn_compute(a, lds, u, wid, lane, qf0, qf1);
                            __syncthreads();
                        }
                        if (r + 1 < nr) {
                            const int u = ATT_UNIT(r + 1); const bf16x8 qf0 = qB0, qf1 = qB1;
                            if (r + 2 < nr) attn_stage(lds, tid, kvA, vvA);
                            if (r + 3 < nr) { const int un = ATT_UNIT(r + 3); attn_load(a, un, tid, kvB, vvB); attn_loadq(a, un, wid, lane, qB0, qB1); }
                            attn_compute(a, lds + ABUF, u, wid, lane, qf0, qf1);
                            __syncthreads();
                        }
                    }
#undef ATT_UNIT
                }
                for (int rq = 0; rq < (((REPEAT_MASK >> 18) & 1) ? 2 : 1); ++rq)
                for (int u = bidx(); u < 1024; u += gridDim.x) { __syncthreads(); spatial_unit(a, lds, u, jl, tid, wid, lane); }
                for (int rq = 0; rq < (((REPEAT_MASK >> 19) & 1) ? 2 : 1); ++rq)
                for (int u = bidx(); u < MS * 8; u += gridDim.x) { __syncthreads(); sample_task(a, lds, u, jl, tid, wid, lane); }
                sample_gate(a, jl, bidx() * 512 + tid, gridDim.x * 512);
            } break;
            case 4: if (PHON(4)) combine_phase(a, wid, lane); break;
            case 11: if (PHON(11)) conv_phase(a, lds, jl, tid, wid, lane); break;
            default: break;
            }
        }
        if (rep + 1 < reps) __syncthreads();
        }
#ifndef SYNC_REPS
#define SYNC_REPS 1
#endif
        if (ph + 1 < ph_hi) { for (int q = 0; q < SYNC_REPS; ++q) { XcdBarrier b2 = xbar; asm volatile("" : "+s"(b2.bar)); xcd_barrier(b2); } }
    }
}

extern "C" void kernel_launch(void* const* d_in, const int* in_sizes, int n_in, void* d_out, int out_size, void* d_ws, size_t ws_size, hipStream_t stream) {
    static int grid = 0;
    if (grid == 0) {
        if (n_in != 23 || (size_t)out_size != O_END || ws_size < WS_END) { fprintf(stderr, "kernel_launch: unexpected sizes n_in %d out %d ws %zu\n", n_in, out_size, ws_size); grid = -1; return; }
        int dev = 0, cus = 0, per_cu = 0;
        (void)hipGetDevice(&dev); (void)hipDeviceGetAttribute(&cus, hipDeviceAttributeMultiprocessorCount, dev);
        if (hipFuncSetAttribute((const void*)fwd_kernel, hipFuncAttributeMaxDynamicSharedMemorySize, LDS_BYTES) != hipSuccess) { fprintf(stderr, "kernel_launch: hipFuncSetAttribute failed\n"); grid = -1; return; }
        if (hipOccupancyMaxActiveBlocksPerMultiprocessor(&per_cu, (const void*)fwd_kernel, 512, LDS_BYTES) != hipSuccess || per_cu < 1) { fprintf(stderr, "kernel_launch: occupancy query failed (%d)\n", per_cu); (void)hipGetLastError(); per_cu = 1; }
        grid = cus * per_cu;
        if (grid <= 0) grid = 256;
    }
    if (grid < 0) return;
    if (hipMemsetAsync((char*)d_ws + WS_BAR, 0, 16384, stream) != hipSuccess) { fprintf(stderr, "kernel_launch: memset of barrier words failed\n"); return; }
    Args a{};
    for (int i = 0; i < 23; ++i) a.in[i] = (GAS const float*)d_in[i];
    a.out = (GAS float*)d_out; a.ws = (GAS unsigned char*)d_ws;
#if MK_MULTI
    for (int ph = 0; ph < N_PHASES; ++ph) { a.ph_lo = ph; a.ph_hi = ph + 1; hipLaunchKernelGGL(fwd_kernel, dim3(grid), dim3(512), LDS_BYTES, stream, a); }
#else
    a.ph_lo = 0; a.ph_hi = N_PHASES;
    void* args[] = {&a};
    hipError_t e = hipLaunchCooperativeKernel((const void*)fwd_kernel, dim3(grid), dim3(512), args, LDS_BYTES, stream);
    if (e != hipSuccess) fprintf(stderr, "cooperative launch failed: %s (grid %d)\n", hipGetErrorString(e), grid);
#endif
}
```

```cpp
#include <hip/hip_runtime.h>
#include <hip/hip_cooperative_groups.h>
#include <cstdio>
#include <cstdint>
#include <cmath>
namespace cg = cooperative_groups;
namespace pg8 {
#define PG8_LAS __attribute__((address_space(3)))
typedef unsigned short bf16_t;
typedef short bf16x8 __attribute__((ext_vector_type(8)));
typedef float f32x4 __attribute__((ext_vector_type(4)));
typedef unsigned u32x4 __attribute__((ext_vector_type(4)));
constexpr int BM = 256, BK = 64, HALF = 128, HTB = HALF * BK * 2  , STAGE_BYTES = 8 * HTB, NXCD = 8, WGM = 4;

__host__ __device__ __forceinline__ int lds_byte(int r, int c) { const int st = (r >> 4) * 2 + (c >> 5), rr = r & 15, cc = c & 31, ob = rr * 64 + cc * 2; return st * 1024 + (ob ^ (((ob >> 9) & 1) << 5)); }
__host__ __device__ __forceinline__ void stage_rc(int b, int& R, int& C) { const int st = b / 1024, sb = b % 1024, swz = sb ^ (((sb >> 9) & 1) << 5); R = (st >> 1) * 16 + swz / 64; C = (st & 1) * 32 + (swz % 64) / 2; }
__host__ __device__ __forceinline__ int perm32(int rho) { const int n = rho >> 4, i = rho & 15; return 8 * (i >> 2) + 4 * n + (i & 3); }

struct Unit { int pm, pn; };
struct Gemm { const bf16_t* A; const bf16_t* Bt; int M, N, K; };

struct StaticOrder {
    int nM, nN, nwg, G, c;
    __host__ __device__ void init(int M, int N, int G_, int c_) { nM = M / BM; nN = N / BM; nwg = nM * nN; G = G_; c = c_; }
    __host__ __device__ bool next(int i, Unit& u) const {
        const long L = (long)i * G + c; if (L >= nwg) return false;
        int wgid = (int)L; { const int q = nwg / NXCD, r = nwg % NXCD, xcd = wgid % NXCD, off = wgid / NXCD; wgid = (xcd < r ? xcd * (q + 1) : r * (q + 1) + (xcd - r) * q) + off; }
        const int nig = WGM * nN, gid = wgid / nig, fm = gid * WGM, gsz = (nM - fm) < WGM ? (nM - fm) : WGM;
        u.pm = fm + ((wgid % nig) % gsz); u.pn = (wgid % nig) / gsz; return true;
    }
    __device__ __forceinline__ void a_ready(const Unit&) const {}
    __device__ __forceinline__ void done(const Unit&) const {}
};
typedef float f32x2 __attribute__((ext_vector_type(2)));
typedef __bf16 bf16x2v __attribute__((ext_vector_type(2)));
__device__ __forceinline__ unsigned pkbf(float lo, float hi) { f32x2 v = {lo, hi}; bf16x2v b = __builtin_convertvector(v, bf16x2v); return __builtin_bit_cast(unsigned, b); }
template <class Epi, class Sched, bool ALIGN_EPI = false, bool SP2 = false>
__device__ __forceinline__ void gemm_phase(PG8_LAS unsigned char* lds, const Gemm g, const Sched& S, const Epi& E, const int tid_in) {
    const int tid = tid_in, wid = __builtin_amdgcn_readfirstlane(tid >> 6), lane = tid & 63, wr = wid >> 2, wc = wid & 3, fr = lane & 15, fq = lane >> 4;
    const int K = g.K, nt = K / BK;
    unsigned voffA[2], voffB[2];
#pragma unroll
    for (int i = 0; i < 2; ++i) { int R, C; stage_rc(tid * 16 + i * 8192, R, C); const int Rb = Epi::PERM ? ((R & ~31) + perm32(R & 31)) : R;
        voffA[i] = (unsigned)(R * K + C) * 2u; voffB[i] = (unsigned)(Rb * K + C) * 2u; }
    const size_t kstep = (size_t)(BK * 2);
    const size_t hstep = (size_t)HALF * K * 2;
    const size_t tstep = 2 * hstep;
    const unsigned ldsw = (unsigned)wid * 1024u;
    const int aoff = lds_byte(wr * 64 + fr, fq * 8), boff = lds_byte(wc * 32 + fr, fq * 8);
#define PG8_SA(b, h) (((b) * 2 + (h)) * HTB)
#define PG8_SB(b, h) ((4 + (b) * 2 + (h)) * HTB)
#define PG8_STAGE(bufoff, gbase, voff) do { _Pragma("unroll") for (int _i = 0; _i < 2; ++_i) \
        __builtin_amdgcn_global_load_lds((const unsigned*)((const char*)(gbase) + (voff)[_i]), (PG8_LAS unsigned*)(lds + (bufoff) + ldsw + _i * 8192), 16, 0, 0); } while (0)
#define PG8_LDA(dst, b, h) do { _Pragma("unroll") for (int m = 0; m < 4; ++m) _Pragma("unroll") for (int k = 0; k < 2; ++k) dst[m][k] = *(const PG8_LAS bf16x8*)(lds + PG8_SA(b, h) + aoff + m * 2048 + k * 1024); } while (0)
#define PG8_LDB(dst, b, h) do { _Pragma("unroll") for (int n = 0; n < 2; ++n) _Pragma("unroll") for (int k = 0; k < 2; ++k) dst[n][k] = *(const PG8_LAS bf16x8*)(lds + PG8_SB(b, h) + boff + n * 2048 + k * 1024); } while (0)
#define PG8_MMA(ai, bj, At, Bt) do { __builtin_amdgcn_s_setprio(1); _Pragma("unroll") for (int m = 0; m < 4; ++m) _Pragma("unroll") for (int n = 0; n < 2; ++n) _Pragma("unroll") for (int k = 0; k < 2; ++k) \
        acc[ai][bj][m][n] = __builtin_amdgcn_mfma_f32_16x16x32_bf16(Bt[n][k], At[m][k], acc[ai][bj][m][n], 0, 0, 0); __builtin_amdgcn_s_setprio(0); } while (0)
#define PG8_WAIT_V(n) asm volatile("s_waitcnt vmcnt(" #n ")" ::: "memory")
#define PG8_WAIT_L(n) asm volatile("s_waitcnt lgkmcnt(" #n ")" ::: "memory")
#define PG8_BAR __builtin_amdgcn_s_barrier()
#define PG8_SCHED __builtin_amdgcn_sched_barrier(0)
    Unit cur, nxt; int ui = 0;
    if (!S.next(0, cur)) return;
    f32x4 acc[2][2][4][2];
#pragma unroll
    for (int a = 0; a < 2; ++a)
#pragma unroll
        for (int b = 0; b < 2; ++b)
#pragma unroll
            for (int m = 0; m < 4; ++m)
#pragma unroll
                for (int n = 0; n < 2; ++n) acc[a][b][m][n] = (f32x4){0.f, 0.f, 0.f, 0.f};
    bf16x8 At[4][2], B0[2][2], B1[2][2];
    const char* cA = (const char*)g.A + (size_t)cur.pm * tstep; const char* cB = (const char*)g.Bt + (size_t)cur.pn * tstep;
    S.a_ready(cur);
    if constexpr (SP2) {
        PG8_STAGE(PG8_SB(0, 0), cB, voffB); PG8_STAGE(PG8_SB(0, 1), cB + hstep, voffB); PG8_STAGE(PG8_SA(0, 0), cA, voffA); PG8_STAGE(PG8_SA(0, 1), cA + hstep, voffA);
        if (wr == 1) PG8_BAR;
        PG8_WAIT_V(2); PG8_BAR;
        PG8_STAGE(PG8_SB(1, 0), cB + kstep, voffB); PG8_STAGE(PG8_SA(1, 0), cA + kstep, voffA); PG8_STAGE(PG8_SB(1, 1), cB + hstep + kstep, voffB);
        PG8_WAIT_V(6); PG8_BAR;
    } else {
        PG8_STAGE(PG8_SB(0, 0), cB, voffB); PG8_STAGE(PG8_SA(0, 0), cA, voffA); PG8_STAGE(PG8_SB(0, 1), cB + hstep, voffB); PG8_STAGE(PG8_SA(0, 1), cA + hstep, voffA);
        if (wr == 1) PG8_BAR;
        PG8_WAIT_V(4); PG8_BAR;
        PG8_STAGE(PG8_SB(1, 0), cB + kstep, voffB); PG8_STAGE(PG8_SA(1, 0), cA + kstep, voffA); PG8_STAGE(PG8_SB(1, 1), cB + hstep + kstep, voffB);
        PG8_WAIT_V(6); PG8_BAR;
    }
    for (;;) {
        const bool has_next = S.next(ui + 1, nxt);
        const char* nA = has_next ? (const char*)g.A + (size_t)nxt.pm * tstep : cA; const char* nB = has_next ? (const char*)g.Bt + (size_t)nxt.pn * tstep : cB;
        for (int t = 0; t < nt; t += 2) {
            const bool last = (t == nt - 2);
            const char* a1 = cA + (size_t)(t + 1) * kstep;
            const char* a2 = last ? nA : cA + (size_t)(t + 2) * kstep; const char* b2 = last ? nB : cB + (size_t)(t + 2) * kstep;
            const char* a3 = a2 + kstep; const char* b3 = b2 + kstep;
            if (last && has_next) S.a_ready(nxt);
            if constexpr (SP2) {
            PG8_LDB(B0, 0, 0); PG8_LDB(B1, 0, 1); PG8_SCHED; PG8_LDA(At, 0, 0); PG8_STAGE(PG8_SA(1, 1), a1 + hstep, voffA);
            PG8_WAIT_V(8); PG8_WAIT_L(0); PG8_BAR; PG8_MMA(0, 0, At, B0); PG8_MMA(0, 1, At, B1); PG8_BAR; PG8_SCHED;
            PG8_LDA(At, 0, 1); PG8_STAGE(PG8_SB(0, 0), b2, voffB); PG8_STAGE(PG8_SB(0, 1), b2 + hstep, voffB); PG8_STAGE(PG8_SA(0, 0), a2, voffA);
            PG8_WAIT_V(8); PG8_WAIT_L(0); PG8_BAR; PG8_MMA(1, 0, At, B0); PG8_MMA(1, 1, At, B1); PG8_BAR; PG8_SCHED;
            PG8_LDB(B0, 1, 0); PG8_LDB(B1, 1, 1); PG8_SCHED; PG8_LDA(At, 1, 0); PG8_STAGE(PG8_SA(0, 1), a2 + hstep, voffA);
            PG8_WAIT_V(8); PG8_WAIT_L(0); PG8_BAR; PG8_MMA(0, 0, At, B0); PG8_MMA(0, 1, At, B1); PG8_BAR; PG8_SCHED;
            PG8_LDA(At, 1, 1); PG8_STAGE(PG8_SB(1, 0), b3, voffB); PG8_STAGE(PG8_SB(1, 1), b3 + hstep, voffB); PG8_STAGE(PG8_SA(1, 0), a3, voffA);
            PG8_WAIT_V(8); PG8_WAIT_L(0); PG8_BAR; PG8_MMA(1, 0, At, B0); PG8_MMA(1, 1, At, B1); PG8_BAR; PG8_SCHED;
            } else {
            PG8_LDB(B0, 0, 0); PG8_SCHED; PG8_LDA(At, 0, 0); PG8_STAGE(PG8_SA(1, 1), a1 + hstep, voffA);
            PG8_WAIT_L(8); PG8_BAR; PG8_WAIT_L(0); PG8_MMA(0, 0, At, B0); PG8_BAR; PG8_SCHED;
            PG8_LDB(B1, 0, 1); PG8_STAGE(PG8_SB(0, 0), b2, voffB);
            PG8_BAR; PG8_WAIT_L(0); PG8_MMA(0, 1, At, B1); PG8_BAR;
            PG8_LDA(At, 0, 1); PG8_STAGE(PG8_SA(0, 0), a2, voffA);
            PG8_BAR; PG8_WAIT_L(0); PG8_MMA(1, 0, At, B0); PG8_BAR; PG8_SCHED;
            PG8_STAGE(PG8_SB(0, 1), b2 + hstep, voffB);
            PG8_WAIT_V(6); PG8_BAR; PG8_MMA(1, 1, At, B1); PG8_BAR;
            PG8_LDB(B0, 1, 0); PG8_SCHED; PG8_LDA(At, 1, 0); PG8_STAGE(PG8_SA(0, 1), a2 + hstep, voffA);
            PG8_WAIT_L(8); PG8_BAR; PG8_WAIT_L(0); PG8_MMA(0, 0, At, B0); PG8_BAR; PG8_SCHED;
            PG8_LDB(B1, 1, 1); PG8_STAGE(PG8_SB(1, 0), b3, voffB);
            PG8_BAR; PG8_WAIT_L(0); PG8_MMA(0, 1, At, B1); PG8_BAR;
            PG8_LDA(At, 1, 1); PG8_STAGE(PG8_SA(1, 0), a3, voffA);
            PG8_BAR; PG8_WAIT_L(0); PG8_MMA(1, 0, At, B0); PG8_BAR; PG8_SCHED;
            PG8_STAGE(PG8_SB(1, 1), b3 + hstep, voffB);
            PG8_WAIT_V(6); PG8_BAR; PG8_MMA(1, 1, At, B1); PG8_BAR;
            }
        }
        if constexpr (ALIGN_EPI) { if (wr == 0) PG8_BAR; }
        if constexpr (!Epi::AFTER_DRAIN) { int fr2 = fr, fq2 = fq; asm volatile("" : "+v"(fr2), "+v"(fq2));   E(acc, cur, wr, wc, fr2, fq2); S.done(cur); }
        if (!has_next) break;
#pragma unroll
        for (int a = 0; a < 2; ++a)
#pragma unroll
            for (int b = 0; b < 2; ++b)
#pragma unroll
                for (int m = 0; m < 4; ++m)
#pragma unroll
                    for (int n = 0; n < 2; ++n) acc[a][b][m][n] = (f32x4){0.f, 0.f, 0.f, 0.f};
        cur = nxt; cA = nA; cB = nB; ++ui;
        if constexpr (ALIGN_EPI) { if (wr == 1) PG8_BAR; }
    }
    PG8_WAIT_V(0);
    if constexpr (!ALIGN_EPI) { if (wr == 0) PG8_BAR; }
    PG8_BAR;
    if constexpr (Epi::AFTER_DRAIN) { E.fused(acc, cur, wr, wc, fr, fq, lds, wid, lane); S.done(cur); }
#undef PG8_SA
#undef PG8_SB
#undef PG8_STAGE
#undef PG8_LDA
#undef PG8_LDB
#undef PG8_MMA
#undef PG8_WAIT_V
#undef PG8_WAIT_L
#undef PG8_BAR
#undef PG8_SCHED
}
}
#define LAS __attribute__((address_space(3)))
typedef unsigned short bf16;
typedef short bf16x8 __attribute__((ext_vector_type(8)));
typedef short s16x4 __attribute__((ext_vector_type(4)));
typedef float f32x4 __attribute__((ext_vector_type(4)));
typedef unsigned u32x4 __attribute__((ext_vector_type(4)));
typedef unsigned u32x2 __attribute__((ext_vector_type(2)));

constexpr int DM = 1024, MP = 16384, MS = 32, MT = MP + MS, MPAD = 16640, SEQ = 2048, NB = 8;
constexpr int ZW = 2560, FF = 4096;
constexpr float EPS = 1e-6f;
constexpr size_t O_YP = 0, O_YS = 16777216, O_AKP = 16809984, O_AVP = 33587200, O_AKS = 50364416, O_AVS = 50397184,
                 O_BVP = 50429952, O_BVS = 51478528, O_CCP = 51511296, O_CCS = 52002816, O_END = 53968896;
constexpr size_t MiB = 1u << 20;
constexpr size_t WS_ROPE = 1 * MiB, WS_WSP = 2 * MiB, WS_ZS = 3 * MiB, WS_RS = 4 * MiB;
constexpr size_t WS_WUP = 8 * MiB, WS_WDN = 40 * MiB, WS_WIN = 72 * MiB, WS_WOUT = 82 * MiB, WS_WCI = 86 * MiB, WS_WCO = 94 * MiB;
constexpr size_t WS_N = 100 * MiB, WS_Z = 134 * MiB, WS_Q = 216 * MiB, WS_K = 233 * MiB, WS_V = 250 * MiB, WS_U = 267 * MiB, WS_VB = 284 * MiB;
constexpr size_t WS_OP = 301 * MiB, WS_LP = 350 * MiB, WS_CAT = 352 * MiB, WS_HID = 386 * MiB, WS_X = 516 * MiB, WS_Y = 550 * MiB, WS_END = 584 * MiB;
constexpr int LDS_BYTES = 163840, LDS_BAR_OFF = 148480;
constexpr size_t WS_BAR = 0;

typedef unsigned long long rs_t;
__device__ __forceinline__ rs_t rs_enc(float s) { return (rs_t)(s * 1048576.f + 0.5f); }
__device__ __forceinline__ float rs_scale(rs_t v) { return rsqrtf((float)v * (1.f / (1048576.f * 1024.f)) + 1e-6f); }
#define GAS __attribute__((address_space(1)))
struct Args { GAS const float* in[23]; GAS float* out; GAS unsigned char* ws; int ph_lo, ph_hi; };
typedef const __attribute__((address_space(4))) Args* ArgsK;
#define AIN(a, i) ((const float*)(a)->in[i])
#define AWS(a) ((unsigned char*)(a)->ws)
#define AOUT(a) ((float*)(a)->out)
enum { I_XP = 0, I_XS, I_CK, I_CV, I_CST, I_GMIX, I_GFFN, I_WUP, I_WDN, I_WIN, I_QG, I_KG, I_VBG, I_VBB, I_WSP, I_BSP, I_WOUT, I_WCI, I_WDW, I_BDW, I_CG, I_CB, I_WCO };

__device__ __forceinline__ int bidx() { int b = (int)blockIdx.x; asm volatile("" : "+s"(b)); return b; }
__device__ __forceinline__ float wave_sum(float v) {
#pragma unroll
    for (int o = 1; o < 64; o <<= 1) v += __shfl_xor(v, o);
    return v;
}
__device__ __forceinline__ float wave_max(float v) {
#pragma unroll
    for (int o = 1; o < 64; o <<= 1) v = fmaxf(v, __shfl_xor(v, o));
    return v;
}
__device__ __forceinline__ float bflo(unsigned u) { return __uint_as_float(u << 16); }
__device__ __forceinline__ float bfhi(unsigned u) { return __uint_as_float(u & 0xffff0000u); }
__device__ __forceinline__ unsigned f2bf(float f) { unsigned u = __float_as_uint(f); return (u + 0x7fffu + ((u >> 16) & 1u)) >> 16; }
__device__ __forceinline__ unsigned pk2(float lo, float hi) { return pg8::pkbf(lo, hi); }
__device__ __forceinline__ float gelu_tanh(float x) {
    const float y = 0.7978845608028654f * (x + 0.044715f * x * x * x);
    const float t = 1.f - 2.f * __builtin_amdgcn_rcpf(__expf(2.f * y) + 1.f);
    return 0.5f * x * (1.f + t);
}

__device__ __forceinline__ void transpose_item(const float* W, int K, int N, bf16* WT, bool glu, const float* gk, int item, int lane) {
    const int nblk = N / 32, i0 = 2 * item, kb = i0 / nblk, nb = i0 % nblk, k0 = 64 * kb, n0 = 32 * nb;
    const int nq = lane & 7, kq = lane >> 3;
    const float* src = W + (size_t)(k0 + 8 * kq) * N + n0 + 4 * nq;
    f32x4 v[2][8];
#pragma unroll
    for (int h2 = 0; h2 < 2; ++h2)
#pragma unroll
        for (int i = 0; i < 8; ++i) v[h2][i] = __builtin_nontemporal_load((const f32x4*)(src + (size_t)i * N + 32 * h2));
    if (gk) {
        const f32x4 ga = *(const f32x4*)(gk + k0 + 8 * kq), gb = *(const f32x4*)(gk + k0 + 8 * kq + 4);
#pragma unroll
        for (int h2 = 0; h2 < 2; ++h2)
#pragma unroll
            for (int i = 0; i < 4; ++i) { v[h2][i] = v[h2][i] * ga[i]; v[h2][4 + i] = v[h2][4 + i] * gb[i]; }
    }
#pragma unroll
    for (int h2 = 0; h2 < 2; ++h2) {
        const int nn = n0 + 32 * h2;
        const int d0 = glu ? (256 * ((nn & 1023) >> 7) + 128 * (nn >> 10) + (nn & 127)) : nn;
        bf16* dst = WT + (size_t)(d0 + 4 * nq) * K + k0 + 8 * kq;
#pragma unroll
        for (int j = 0; j < 4; ++j) { u32x4 o; o.x = pk2(v[h2][0][j], v[h2][1][j]); o.y = pk2(v[h2][2][j], v[h2][3][j]); o.z = pk2(v[h2][4][j], v[h2][5][j]); o.w = pk2(v[h2][6][j], v[h2][7][j]);
            __builtin_nontemporal_store(o, (u32x4*)(dst + (size_t)j * K)); }
    }
}

__device__ __forceinline__ void convert_set(ArgsK a, int set, int widx, int nw, int lane) {
    unsigned char* ws = AWS(a);
    constexpr int IPL[6] = {16 * 64, 64 * 16, 16 * 40, 16 * 16, 16 * 32, 16 * 16};
    int l0[6], l1[6];
    if (set == 0)      { l0[0] = 0; l1[0] = 0; l0[1] = 0; l1[1] = 0; l0[2] = 0; l1[2] = 1; l0[3] = 0; l1[3] = 0; l0[4] = 0; l1[4] = 0; l0[5] = 0; l1[5] = 0; }
    else if (set == 1) { l0[0] = 0; l1[0] = 2; l0[1] = 0; l1[1] = 2; l0[2] = 1; l1[2] = 2; l0[3] = 0; l1[3] = 1; l0[4] = 0; l1[4] = 1; l0[5] = 0; l1[5] = 1; }
    else               { l0[0] = 2; l1[0] = 4; l0[1] = 2; l1[1] = 4; l0[2] = 0; l1[2] = 0; l0[3] = 1; l1[3] = 2; l0[4] = 1; l1[4] = 2; l0[5] = 1; l1[5] = 2; }
    int cnt[6], total = 0;
#pragma unroll
    for (int m = 0; m < 6; ++m) { cnt[m] = (l1[m] - l0[m]) * IPL[m]; total += cnt[m]; }
    for (int it = widx; it < total; it += nw) {
        int r = it;
        if (r < cnt[0]) { const int l = l0[0] + r / IPL[0]; transpose_item(AIN(a, I_WUP) + (size_t)l * DM * FF, DM, FF, (bf16*)(ws + WS_WUP) + (size_t)l * DM * FF, false, AIN(a, I_GFFN) + l * DM, r % IPL[0], lane); continue; } r -= cnt[0];
        if (r < cnt[1]) { const int l = l0[1] + r / IPL[1]; transpose_item(AIN(a, I_WDN) + (size_t)l * DM * FF, FF, DM, (bf16*)(ws + WS_WDN) + (size_t)l * DM * FF, false, nullptr, r % IPL[1], lane); continue; } r -= cnt[1];
        if (r < cnt[2]) { const int l = l0[2] + r / IPL[2]; transpose_item(AIN(a, I_WIN) + (size_t)l * DM * ZW, DM, ZW, (bf16*)(ws + WS_WIN) + (size_t)l * DM * ZW, false, AIN(a, I_GMIX) + 2 * l * DM, r % IPL[2], lane); continue; } r -= cnt[2];
        if (r < cnt[3]) { const int l = l0[3] + r / IPL[3]; transpose_item(AIN(a, I_WOUT) + (size_t)l * DM * DM, DM, DM, (bf16*)(ws + WS_WOUT) + (size_t)l * DM * DM, false, nullptr, r % IPL[3], lane); continue; } r -= cnt[3];
        if (r < cnt[4]) { const int l = l0[4] + r / IPL[4]; transpose_item(AIN(a, I_WCI) + (size_t)l * DM * 2048, DM, 2048, (bf16*)(ws + WS_WCI) + (size_t)l * DM * 2048, true, AIN(a, I_GMIX) + (2 * l + 1) * DM, r % IPL[4], lane); continue; } r -= cnt[4];
        { const int l = l0[5] + r / IPL[5]; transpose_item(AIN(a, I_WCO) + (size_t)l * DM * DM, DM, DM, (bf16*)(ws + WS_WCO) + (size_t)l * DM * DM, false, nullptr, r % IPL[5], lane); }
    }
}

__device__ __forceinline__ void prologue(ArgsK a, LAS unsigned char* lds, int tid, int wid, int lane) {
    unsigned char* ws = AWS(a);
    const int gw = bidx() * 8 + wid, NGW = gridDim.x * 8;
    convert_set(a, 0, gw, NGW, lane);
    { rs_t* rs = (rs_t*)(ws + WS_RS); const int gt0 = bidx() * 512 + tid, NGT0 = gridDim.x * 512;
      for (int e = gt0; e < 7 * MPAD; e += NGT0) rs[MPAD + e] = 0ull; }
    { bf16* nout = (bf16*)(ws + WS_N); rs_t* rs0 = (rs_t*)(ws + WS_RS);
      for (int row = gw; row < MT; row += NGW) {
        const float* src = (row < MP) ? AIN(a, I_XP) + (size_t)row * DM : AIN(a, I_XS) + (size_t)(row - MP) * DM;
        f32x4 v[4]; float s = 0.f;
#pragma unroll
        for (int j = 0; j < 4; ++j) v[j] = *(const f32x4*)(src + 4 * lane + 256 * j);
        __builtin_amdgcn_sched_barrier(0);
#pragma unroll
        for (int j = 0; j < 4; ++j) s += (v[j].x * v[j].x + v[j].y * v[j].y) + (v[j].z * v[j].z + v[j].w * v[j].w);
        s = wave_sum(s); if (lane == 0) rs0[row] = rs_enc(s);
        bf16* dst = nout + (size_t)row * DM;
#pragma unroll
        for (int j = 0; j < 4; ++j) { u32x2 o; o.x = pk2(v[j].x, v[j].y); o.y = pk2(v[j].z, v[j].w); *(u32x2*)(dst + 4 * lane + 256 * j) = o; }
      } }
    const int gt = bidx() * 512 + tid, NGT = gridDim.x * 512;
    for (int e = gt; e < 2049 * 32; e += NGT) {
        const int pi = e >> 5, i = e & 31; const float pos = (pi < 2048) ? (float)pi : 8192.f;
        const float inv = powf(10000.f, -(float)i / 32.f);
        const float ang = pos * inv;
        double rev = (double)ang * 0.15915494309189533577; rev -= floor(rev);
        const float fr = (float)rev;
        float2 cs; cs.x = __builtin_amdgcn_cosf(fr); cs.y = __builtin_amdgcn_sinf(fr);
        ((float2*)(ws + WS_ROPE))[e] = cs;
    }
    for (int e = gt; e < 2 * 8 * 128 * 128; e += NGT) {
        const int jj = e & 127, i = (e >> 7) & 127; const float w = (jj <= i) ? AIN(a, I_WSP)[e] : 0.f;
        ((bf16*)(ws + WS_WSP))[e] = (bf16)f2bf(w);
    }
}

__device__ __forceinline__ void norm_phase(const float* hp, const float* hs, const float* g, bf16* nout, int wid, int lane) {
    const int gw = bidx() * 8 + wid, NGW = gridDim.x * 8;
    f32x4 gv[4];
#pragma unroll
    for (int j = 0; j < 4; ++j) gv[j] = *(const f32x4*)(g + 4 * lane + 256 * j);
    for (int row = gw; row < MT; row += NGW) {
        const float* src = (row < MP) ? hp + (size_t)row * DM : hs + (size_t)(row - MP) * DM;
        f32x4 v[4]; float s = 0.f;
#pragma unroll
        for (int j = 0; j < 4; ++j) { v[j] = *(const f32x4*)(src + 4 * lane + 256 * j); s += (v[j].x * v[j].x + v[j].y * v[j].y) + (v[j].z * v[j].z + v[j].w * v[j].w); }
        const float r = rsqrtf(wave_sum(s) * (1.f / DM) + EPS);
        bf16* dst = nout + (size_t)row * DM;
#pragma unroll
        for (int j = 0; j < 4; ++j) { u32x2 o; o.x = pk2(v[j].x * r * gv[j].x, v[j].y * r * gv[j].y); o.y = pk2(v[j].z * r * gv[j].z, v[j].w * r * gv[j].w); *(u32x2*)(dst + 4 * lane + 256 * j) = o; }
    }
}

__device__ __forceinline__ void post_phase(ArgsK a, int jl, int wid, int lane) {
    unsigned char* ws = AWS(a);
    const bf16* Z = (const bf16*)(ws + WS_Z);
    bf16* Qb = (bf16*)(ws + WS_Q); bf16* Kb = (bf16*)(ws + WS_K); bf16* Vb = (bf16*)(ws + WS_V); bf16* Ub = (bf16*)(ws + WS_U); bf16* VBb = (bf16*)(ws + WS_VB);
    const float2* rope = (const float2*)(ws + WS_ROPE);
    const int gw = bidx() * 8 + wid, NGW = gridDim.x * 8;
    const int hh = lane >> 3, sub = lane & 7;
    f32x4 gqk[2][2];
#pragma unroll
    for (int which = 0; which < 2; ++which) { const float* g = AIN(a, which ? I_KG : I_QG) + jl * 64; gqk[which][0] = *(const f32x4*)(g + sub * 4); gqk[which][1] = *(const f32x4*)(g + 32 + sub * 4); }
    const float* gvb = AIN(a, I_VBG) + jl * 512 + lane * 8; const float* bvb = AIN(a, I_VBB) + jl * 512 + lane * 8;
    const f32x4 ga = *(const f32x4*)gvb, gb = *(const f32x4*)(gvb + 4), ba = *(const f32x4*)bvb, bb4 = *(const f32x4*)(bvb + 4);
    for (int row = gw; row < MT; row += NGW) {
        const bool samp = row >= MP; const int t = row & (SEQ - 1), bb = row >> 11, ns = row - MP;
        const int pidx = samp ? 2048 : t;
        const bf16* z = Z + (size_t)row * ZW;
        u32x2 zlo[2], zhi[2];
#pragma unroll
        for (int which = 0; which < 2; ++which) { const bf16* src = z + which * 512 + hh * 64 + sub * 4; zlo[which] = *(const u32x2*)src; zhi[which] = *(const u32x2*)(src + 32); }
        const u32x4 zv = *(const u32x4*)(z + 1024 + lane * 8), zb = *(const u32x4*)(z + 2048 + lane * 8);
        float cs[4], sn[4];
#pragma unroll
        for (int i = 0; i < 4; ++i) { const float2 c2 = rope[pidx * 32 + sub * 4 + i]; cs[i] = c2.x; sn[i] = c2.y; }
#pragma unroll
        for (int which = 0; which < 2; ++which) {
            const u32x2 lo = zlo[which], hi = zhi[which];
            float x1[4] = {bflo(lo.x), bfhi(lo.x), bflo(lo.y), bfhi(lo.y)}, x2[4] = {bflo(hi.x), bfhi(hi.x), bflo(hi.y), bfhi(hi.y)};
            float ss = 0.f;
#pragma unroll
            for (int i = 0; i < 4; ++i) ss += x1[i] * x1[i] + x2[i] * x2[i];
            ss += __shfl_xor(ss, 1); ss += __shfl_xor(ss, 2); ss += __shfl_xor(ss, 4);
            const float r = rsqrtf(ss * (1.f / 64.f) + EPS);
            const f32x4 g1 = gqk[which][0], g2 = gqk[which][1];
            f32x4 o1, o2;
#pragma unroll
            for (int i = 0; i < 4; ++i) { const float y1 = x1[i] * r * g1[i], y2 = x2[i] * r * g2[i]; o1[i] = y1 * cs[i] - y2 * sn[i]; o2[i] = y2 * cs[i] + y1 * sn[i]; }
            bf16* dst = (which ? Kb : Qb) + (size_t)row * 512 + hh * 64 + sub * 4;
            u32x2 p1, p2; p1.x = pk2(o1[0], o1[1]); p1.y = pk2(o1[2], o1[3]); p2.x = pk2(o2[0], o2[1]); p2.y = pk2(o2[2], o2[3]);
            *(u32x2*)dst = p1; *(u32x2*)(dst + 32) = p2;
            if (which == 1) {
                float* ok = samp ? AOUT(a) + O_AKS + (size_t)(jl * MS + ns) * 512 : AOUT(a) + O_AKP + ((size_t)jl * MP + row) * 512;
                __builtin_nontemporal_store(o1, (f32x4*)(ok + hh * 64 + sub * 4)); __builtin_nontemporal_store(o2, (f32x4*)(ok + hh * 64 + 32 + sub * 4));
            }
        }
        {
            const u32x4 vv = zv;
            float* ov = samp ? AOUT(a) + O_AVS + (size_t)(jl * MS + ns) * 512 : AOUT(a) + O_AVP + ((size_t)jl * MP + row) * 512;
            __builtin_nontemporal_store((f32x4){bflo(vv.x), bfhi(vv.x), bflo(vv.y), bfhi(vv.y)}, (f32x4*)(ov + lane * 8));
            __builtin_nontemporal_store((f32x4){bflo(vv.z), bfhi(vv.z), bflo(vv.w), bfhi(vv.w)}, (f32x4*)(ov + lane * 8 + 4));
        }
        {
            const u32x4 bv = zb;
            float x[8] = {gelu_tanh(bflo(bv.x)), gelu_tanh(bfhi(bv.x)), gelu_tanh(bflo(bv.y)), gelu_tanh(bfhi(bv.y)), gelu_tanh(bflo(bv.z)), gelu_tanh(bfhi(bv.z)), gelu_tanh(bflo(bv.w)), gelu_tanh(bfhi(bv.w))};
            float s = 0.f;
#pragma unroll
            for (int i = 0; i < 8; ++i) s += x[i];
            const float mean = wave_sum(s) * (1.f / 512.f); float q = 0.f;
#pragma unroll
            for (int i = 0; i < 8; ++i) { x[i] -= mean; q += x[i] * x[i]; }
            const float rstd = rsqrtf(wave_sum(q) * (1.f / 512.f) + EPS);

            f32x4 ya, yb;
#pragma unroll
            for (int i = 0; i < 4; ++i) { ya[i] = x[i] * rstd * ga[i] + ba[i]; yb[i] = x[4 + i] * rstd * gb[i] + bb4[i]; }
            u32x4 o; o.x = pk2(ya[0], ya[1]); o.y = pk2(ya[2], ya[3]); o.z = pk2(yb[0], yb[1]); o.w = pk2(yb[2], yb[3]);
            *(u32x4*)(VBb + (size_t)row * 512 + lane * 8) = o;
            float* ob = nullptr;
            if (samp) ob = AOUT(a) + O_BVS + (size_t)(jl * MS + ns) * 512;
            else if (t >= 1920) ob = AOUT(a) + O_BVP + ((size_t)(jl * NB + bb) * 128 + (t - 1920)) * 512;
            if (ob) { *(f32x4*)(ob + lane * 8) = ya; *(f32x4*)(ob + lane * 8 + 4) = yb; }
        }
    }
}

__device__ __forceinline__ void combine_phase(ArgsK a, int wid, int lane) {
    unsigned char* ws = AWS(a);
    const bf16* OP = (const bf16*)(ws + WS_OP); const float* LP = (const float*)(ws + WS_LP); bf16* CAT = (bf16*)(ws + WS_CAT);
    const int gw = bidx() * 8 + wid, NGW = gridDim.x * 8; const int hh = lane >> 3;
    for (int row = gw; row < MP; row += NGW) {
        const u32x4 p0 = *(const u32x4*)(OP + ((size_t)0 * MPAD + row) * 512 + lane * 8), p1 = *(const u32x4*)(OP + ((size_t)1 * MPAD + row) * 512 + lane * 8), p2 = *(const u32x4*)(OP + ((size_t)2 * MPAD + row) * 512 + lane * 8);
        const float l0 = LP[((size_t)0 * MPAD + row) * 8 + hh], l1 = LP[((size_t)1 * MPAD + row) * 8 + hh], l2 = LP[((size_t)2 * MPAD + row) * 8 + hh];
        __builtin_amdgcn_sched_barrier(0);
        const float m = fmaxf(l0, fmaxf(l1, l2)); float e0 = __expf(l0 - m), e1 = __expf(l1 - m), e2 = __expf(l2 - m); const float inv = __builtin_amdgcn_rcpf(e0 + e1 + e2);
        e0 *= inv; e1 *= inv; e2 *= inv;
        u32x4 o;
#pragma unroll
        for (int i = 0; i < 4; ++i) { const float lo = e0 * bflo(p0[i]) + e1 * bflo(p1[i]) + e2 * bflo(p2[i]), hi = e0 * bfhi(p0[i]) + e1 * bfhi(p1[i]) + e2 * bfhi(p2[i]); o[i] = pk2(lo, hi); }
        *(u32x4*)(CAT + (size_t)row * DM + lane * 8) = o;
    }
}
struct GemmCfg { int mode; const bf16* A; const bf16* B; int N, K; bf16* O; int ld; const float* xin; const float* xins; float* yout; bf16* hb; bool first, last; const rs_t* rs; rs_t* rsn; };
__device__ __forceinline__ bool gemm_cfg(ArgsK ap, int ph, GemmCfg& c) {
    unsigned char* ws = AWS(ap); float* out = AOUT(ap);
    const int half = ph >= 16 ? 1 : 0, kind = ph - 16 * half, L = 2 * half + (kind >= 9 ? 1 : 0), jl = half;
    c.mode = -1; c.O = nullptr; c.ld = DM; c.A = (const bf16*)(ws + WS_N); c.B = nullptr; c.N = DM; c.K = DM;
    if (kind == 1) { c.mode = 0; c.B = (const bf16*)(ws + WS_WIN) + (size_t)jl * DM * ZW; c.N = ZW; c.O = (bf16*)(ws + WS_Z); c.ld = ZW; }
    else if (kind == 7 || kind == 14) { c.mode = 1; c.B = (const bf16*)(ws + WS_WUP) + (size_t)L * DM * FF; c.N = FF; c.O = (bf16*)(ws + WS_HID); c.ld = FF; }
    else if (kind == 10) { c.mode = 2; c.B = (const bf16*)(ws + WS_WCI) + (size_t)jl * DM * 2048; c.N = 2048; c.O = (bf16*)(ws + WS_X); }
    else if (kind == 5) { c.mode = 3; c.A = (const bf16*)(ws + WS_CAT); c.B = (const bf16*)(ws + WS_WOUT) + (size_t)jl * DM * DM; }
    else if (kind == 12) { c.mode = 3; c.A = (const bf16*)(ws + WS_Y); c.B = (const bf16*)(ws + WS_WCO) + (size_t)jl * DM * DM; }
    else if (kind == 8 || kind == 15) { c.mode = 3; c.A = (const bf16*)(ws + WS_HID); c.B = (const bf16*)(ws + WS_WDN) + (size_t)L * DM * FF; c.K = FF; }
    c.xin = AIN(ap, I_XP); c.xins = AIN(ap, I_XS); c.yout = out; c.hb = (bf16*)(ws + WS_N); c.first = (ph == 5); c.last = (ph == 31);
    rs_t* rsb = (rs_t*)(ws + WS_RS);
    c.rs = rsb + (size_t)(2 * L + ((kind == 7 || kind == 14) ? 1 : 0)) * MPAD; c.rsn = nullptr;
    if (c.mode == 3) { if (kind == 5 || kind == 12) c.rsn = rsb + (size_t)(2 * L + 1) * MPAD; else if (L < 3) c.rsn = rsb + (size_t)(2 * L + 2) * MPAD; }
    return c.mode >= 0;
}
struct EpiAll {
    static constexpr bool PERM = true, AFTER_DRAIN = false;
    ArgsK ap0; int ph;
    __device__ __forceinline__ void operator()(const f32x4 (&acc)[2][2][4][2], const pg8::Unit& u, int wr, int wc, int fr, int fq) const {
        using pg8::pkbf; constexpr int BM = pg8::BM, HALF = pg8::HALF; typedef pg8::bf16_t bf16_t;
        ArgsK ap = (ArgsK)ap0; asm volatile("" : "+s"(ap));
        GemmCfg c; gemm_cfg(ap, ph, c);
        const int mode = c.mode; bf16_t* O = c.O; const int ldc = c.ld; const rs_t* rs = c.rs; rs_t* rsn = c.rsn;
        const int row0 = u.pm * BM + wr * 64 + fr;
        if (mode == 3) {
            const int col0 = u.pn * BM + wc * 32 + 8 * fq; const float* xin = c.xin; float* yout = c.yout; bf16_t* hb = c.hb; const bool first = c.first, last = c.last;
#pragma unroll
            for (int ai = 0; ai < 2; ++ai) {
                f32x4 bb[4][2][2];
                if (first) {
#pragma unroll
                    for (int m = 0; m < 4; ++m)
#pragma unroll
                        for (int bj = 0; bj < 2; ++bj) { const size_t off = (size_t)(row0 + ai * HALF + m * 16) * 1024 + col0 + bj * HALF; bb[m][bj][0] = *(const f32x4*)(xin + off); bb[m][bj][1] = *(const f32x4*)(xin + off + 4); }
                } else {
                    u32x4 wv[4][2];
#pragma unroll
                    for (int m = 0; m < 4; ++m)
#pragma unroll
                        for (int bj = 0; bj < 2; ++bj) wv[m][bj] = *(const u32x4*)(hb + (size_t)(row0 + ai * HALF + m * 16) * 1024 + col0 + bj * HALF);
#pragma unroll
                    for (int m = 0; m < 4; ++m)
#pragma unroll
                        for (int bj = 0; bj < 2; ++bj) { const u32x4 w = wv[m][bj];
                            bb[m][bj][0] = (f32x4){__uint_as_float(w.x << 16), __uint_as_float(w.x & 0xffff0000u), __uint_as_float(w.y << 16), __uint_as_float(w.y & 0xffff0000u)};
                            bb[m][bj][1] = (f32x4){__uint_as_float(w.z << 16), __uint_as_float(w.z & 0xffff0000u), __uint_as_float(w.w << 16), __uint_as_float(w.w & 0xffff0000u)}; }
                }
#pragma unroll
                for (int m = 0; m < 4; ++m) { const int row = row0 + ai * HALF + m * 16; const size_t off = (size_t)row * 1024 + col0; float ss = 0.f;
#pragma unroll
                    for (int bj = 0; bj < 2; ++bj) {
                        const f32x4 h0 = bb[m][bj][0] + acc[ai][bj][m][0], h1 = bb[m][bj][1] + acc[ai][bj][m][1];
                        if (last) { *(f32x4*)(yout + off + bj * HALF) = h0; *(f32x4*)(yout + off + bj * HALF + 4) = h1; }
                        else { u32x4 w; w.x = pkbf(h0[0], h0[1]); w.y = pkbf(h0[2], h0[3]); w.z = pkbf(h1[0], h1[1]); w.w = pkbf(h1[2], h1[3]); *(u32x4*)(hb + off + bj * HALF) = w; }
                        ss += (h0[0] * h0[0] + h0[1] * h0[1]) + (h0[2] * h0[2] + h0[3] * h0[3]) + (h1[0] * h1[0] + h1[1] * h1[1]) + (h1[2] * h1[2] + h1[3] * h1[3]); }
                    if (rsn) { ss += __shfl_xor(ss, 16); ss += __shfl_xor(ss, 32); if (fq == 0) atomicAdd(rsn + row, rs_enc(ss)); } }
            }
        } else if (mode == 2) {
            const int col0 = u.pn * HALF + wc * 32 + 8 * fq;
            rs_t rv[2][4];
#pragma unroll
            for (int ai = 0; ai < 2; ++ai)
#pragma unroll
                for (int m = 0; m < 4; ++m) rv[ai][m] = rs[row0 + ai * HALF + m * 16];
            __builtin_amdgcn_sched_barrier(0);
#pragma unroll
            for (int ai = 0; ai < 2; ++ai)
#pragma unroll
                for (int m = 0; m < 4; ++m) { const int row = row0 + ai * HALF + m * 16; bf16_t* rowp = O + (size_t)row * ldc + col0;
                    const float sc = rs_scale(rv[ai][m]);
                    f32x4 x0, x1;
#pragma unroll
                    for (int e = 0; e < 4; ++e) { x0[e] = sc * acc[ai][0][m][0][e] * __builtin_amdgcn_rcpf(1.f + __expf(-sc * acc[ai][1][m][0][e])); x1[e] = sc * acc[ai][0][m][1][e] * __builtin_amdgcn_rcpf(1.f + __expf(-sc * acc[ai][1][m][1][e])); }
                    u32x4 w; w.x = pkbf(x0[0], x0[1]); w.y = pkbf(x0[2], x0[3]); w.z = pkbf(x1[0], x1[1]); w.w = pkbf(x1[2], x1[3]);
                    *(u32x4*)rowp = w; }
        } else {
            const int col0 = u.pn * BM + wc * 32 + 8 * fq;
            rs_t rv[2][4];
#pragma unroll
            for (int ai = 0; ai < 2; ++ai)
#pragma unroll
                for (int m = 0; m < 4; ++m) rv[ai][m] = rs[row0 + ai * HALF + m * 16];
            __builtin_amdgcn_sched_barrier(0);
#pragma unroll
            for (int ai = 0; ai < 2; ++ai)
#pragma unroll
                for (int m = 0; m < 4; ++m) { const int row = row0 + ai * HALF + m * 16; bf16_t* rowp = O + (size_t)row * ldc + col0;
                    const float sc = rs_scale(rv[ai][m]);
#pragma unroll
                    for (int bj = 0; bj < 2; ++bj) { f32x4 v0 = acc[ai][bj][m][0] * sc, v1 = acc[ai][bj][m][1] * sc;
                        if (mode == 1) {
#pragma unroll
                            for (int e = 0; e < 4; ++e) { const float a = fmaxf(v0[e], 0.f), b = fmaxf(v1[e], 0.f); v0[e] = a * a; v1[e] = b * b; } }
                        u32x4 w; w.x = pkbf(v0[0], v0[1]); w.y = pkbf(v0[2], v0[3]); w.z = pkbf(v1[0], v1[1]); w.w = pkbf(v1[2], v1[3]);
                        *(u32x4*)(rowp + bj * HALF) = w; } }
        }
    }
};
#define XB_TMO      128
#define XB_XCNT(j)  (256  + 64 * (j))
#define XB_XSUB(j)  (1280 + 64 * (j))
#define XB_XGEN(j)  (2304 + 64 * (j))
#define XB_TOP      3328
#define XB_TOPGEN   3392
#define XCD_BAR_WORDS 3456
#define XB_SPIN_CAP (1u << 18)

__device__ __forceinline__ unsigned xb_ld(unsigned* p)              { return __hip_atomic_load(p, __ATOMIC_RELAXED, __HIP_MEMORY_SCOPE_AGENT); }
__device__ __forceinline__ unsigned xb_add(unsigned* p, unsigned v) { return __hip_atomic_fetch_add(p, v, __ATOMIC_RELAXED, __HIP_MEMORY_SCOPE_AGENT); }
__device__ __forceinline__ unsigned xb_xcc_id() { return (unsigned)__builtin_amdgcn_s_getreg((3 << 11) | 20) & 0xFu; }
#define XB_SPIN(cond, bar) do { unsigned _sp = 0; while (cond) { __builtin_amdgcn_s_sleep(1); \
    if ((++_sp & 255u) == 0u) { if (xb_ld(&(bar)[XB_TMO])) break; if (_sp > XB_SPIN_CAP) { atomicAdd(&(bar)[XB_TMO], 1u); break; } } } } while (0)

struct XcdBarrier {
    unsigned* bar; unsigned x;
    volatile LAS unsigned* st;
};

__device__ __forceinline__ XcdBarrier xcd_barrier_post(unsigned* bar, volatile LAS unsigned* st) {
    XcdBarrier b; b.bar = bar; b.x = xb_xcc_id(); b.st = st;
    if (threadIdx.x == 0) (void)xb_add(&bar[XB_XCNT(b.x)], 1u);
    return b;
}
__device__ __forceinline__ void xcd_barrier_complete(unsigned* bar, unsigned x, unsigned& nloc, unsigned& nx) {
    const unsigned G = gridDim.x * gridDim.y * gridDim.z;
    unsigned sum, cnt, mine, sp = 0u;
    for (;;) {
        sum = 0u; cnt = 0u; mine = 0u;
#pragma unroll
        for (unsigned j = 0; j < 16; ++j) { const unsigned c = xb_ld(&bar[XB_XCNT(j)]); sum += c; cnt += (c > 0u) ? 1u : 0u; mine = (j == x) ? c : mine; }
        if (sum == G) break;
        __builtin_amdgcn_s_sleep(1);
        if ((++sp & 255u) == 0u) { if (xb_ld(&bar[XB_TMO])) break; if (sp > XB_SPIN_CAP) { atomicAdd(&bar[XB_TMO], 1u); break; } }
    }
    nloc = mine > 0u ? mine : 1u; nx = cnt > 0u ? cnt : 1u;
}

__device__ __forceinline__ void xcd_barrier(const XcdBarrier& b) {
    asm volatile("s_waitcnt vmcnt(0)" ::: "memory");
    __syncthreads();
    if (threadIdx.x == 0) {
        unsigned* bar = b.bar;
        __builtin_amdgcn_s_waitcnt(0);
        unsigned nloc = b.st[0], nx = b.st[1];
        if (nloc == 0u) { xcd_barrier_complete(bar, b.x, nloc, nx); b.st[0] = nloc; b.st[1] = nx; }
        const unsigned old = xb_add(&bar[XB_XSUB(b.x)], 1u);
        const unsigned gen = old / nloc;
        if (old + 1u == (gen + 1u) * nloc) {
            __builtin_amdgcn_fence(__ATOMIC_RELEASE, "agent");
            asm volatile("s_waitcnt vmcnt(0)" ::: "memory");
            const unsigned og = xb_add(&bar[XB_TOP], 1u);
            const unsigned tg = og / nx;
            if (og + 1u == (tg + 1u) * nx) xb_add(&bar[XB_TOPGEN], 1u);
            else XB_SPIN(xb_ld(&bar[XB_TOPGEN]) == tg, bar);
            __builtin_amdgcn_fence(__ATOMIC_ACQUIRE, "agent");
            xb_add(&bar[XB_XGEN(b.x)], 1u);
            asm volatile("s_waitcnt vmcnt(0)" ::: "memory");
        } else {
            XB_SPIN(xb_ld(&bar[XB_XGEN(b.x)]) == gen, bar);
            __builtin_amdgcn_fence(__ATOMIC_ACQUIRE, "agent");
            asm volatile("s_waitcnt vmcnt(0)" ::: "memory");
        }
    }
    __syncthreads();
}
constexpr int TS = 144;
constexpr int LDS_KT = 0, LDS_VT = 256 * TS;
__device__ __forceinline__ s16x4 tr_read(LAS unsigned char* p) { return __builtin_bit_cast(s16x4, __builtin_amdgcn_ds_read_tr16_b64_v4i16((LAS s16x4*)p)); }
#define MFMA16(x, y, c) __builtin_amdgcn_mfma_f32_16x16x32_bf16((x), (y), (c), 0, 0, 0)

struct AttnIdx { int br, b, h, dsh, res, qb; size_t rowb; };
__device__ __forceinline__ AttnIdx attn_decode(int unit) {
    AttnIdx x; x.br = unit >> 10; const int rem = unit & 1023, bh = rem >> 4, idx = rem & 15; x.b = bh >> 3; x.h = bh & 7;
    x.dsh = 2 * x.br; const int nbm = (16 >> x.dsh) - 1; x.res = idx >> (4 - x.dsh); x.qb = idx & nbm; x.rowb = (size_t)x.b * SEQ + x.res; return x;
}
__device__ __forceinline__ void attn_load(ArgsK a, int unit, int tid, u32x4 (&kv)[4], u32x4 (&vv)[4]) {
    const bf16* Kb = (const bf16*)(AWS(a) + WS_K); const bf16* Zv = (const bf16*)(AWS(a) + WS_Z) + 1024;
    const AttnIdx x = attn_decode(unit);
#pragma unroll
    for (int it = 0; it < 4; ++it) {
        const int c = tid + 512 * it, kr = c >> 3, ch = c & 7, s0 = 128 * (x.qb - 1) + kr, s = s0 < 0 ? 0 : s0;
        const size_t row = x.rowb + ((size_t)s << x.dsh); kv[it] = *(const u32x4*)(Kb + row * 512 + x.h * 64 + ch * 8); vv[it] = *(const u32x4*)(Zv + row * ZW + x.h * 64 + ch * 8);
    }
}
__device__ __forceinline__ void attn_stage(LAS unsigned char* lds, int tid, const u32x4 (&kv)[4], const u32x4 (&vv)[4]) {
#pragma unroll
    for (int it = 0; it < 4; ++it) { const int c = tid + 512 * it, kr = c >> 3, ch = c & 7;
        *(LAS u32x4*)(lds + LDS_KT + kr * TS + ch * 16) = kv[it]; *(LAS u32x4*)(lds + LDS_VT + kr * TS + ch * 16) = vv[it]; }
}
__device__ __forceinline__ void attn_loadq(ArgsK a, int unit, int wid, int lane, bf16x8& qf0, bf16x8& qf1) {
    const bf16* Qb = (const bf16*)(AWS(a) + WS_Q); const int fr = lane & 15, fq = lane >> 4;
    const AttnIdx x = attn_decode(unit); const int sq = 128 * x.qb + 16 * wid + fr; const size_t rowq = x.rowb + ((size_t)sq << x.dsh);
    qf0 = *(const bf16x8*)(Qb + rowq * 512 + x.h * 64 + fq * 8); qf1 = *(const bf16x8*)(Qb + rowq * 512 + x.h * 64 + 32 + fq * 8);
}
__device__ __forceinline__ void attn_compute(ArgsK a, LAS unsigned char* lds, int unit, int wid, int lane, const bf16x8 qf0, const bf16x8 qf1) {
    unsigned char* ws = AWS(a);
    bf16* OP = (bf16*)(ws + WS_OP); float* LP = (float*)(ws + WS_LP);
    const int fr = lane & 15, fq = lane >> 4;
    const AttnIdx x = attn_decode(unit); const int br = x.br, h = x.h, qb = x.qb, dsh = x.dsh;
    const int sq = 128 * qb + 16 * wid + fr; const size_t rowq = x.rowb + ((size_t)sq << dsh);
    f32x4 S[10];
#pragma unroll
    for (int kp = 0; kp < 9; ++kp) {
        const int kt = wid + kp; LAS unsigned char* ka = lds + LDS_KT + (16 * kt + fr) * TS + fq * 16;
        const bf16x8 x0 = *(const LAS bf16x8*)ka, x1 = *(const LAS bf16x8*)(ka + 64);
        f32x4 acc = {0.f, 0.f, 0.f, 0.f};
        acc = MFMA16(x0, qf0, acc); acc = MFMA16(x1, qf1, acc); S[kp] = acc;
    }
    constexpr float C2 = 0.125f * 1.4426950408889634f;
    float mx = -INFINITY;
#pragma unroll
    for (int kp = 0; kp < 9; ++kp) {
        const bool dead = (qb == 0) && (wid + kp < 8);
#pragma unroll
        for (int v = 0; v < 4; ++v) {
            bool ok = !dead;
            if (kp == 0) ok = ok && (fr <= 4 * fq + v);
            if (kp == 8) ok = ok && (fr >= 4 * fq + v);
            const float sc = ok ? S[kp][v] * C2 : -INFINITY; S[kp][v] = sc; mx = fmaxf(mx, sc);
        }
    }
    mx = fmaxf(mx, __shfl_xor(mx, 16)); mx = fmaxf(mx, __shfl_xor(mx, 32));
    float den = 0.f;
#pragma unroll
    for (int kp = 0; kp < 9; ++kp)
#pragma unroll
        for (int v = 0; v < 4; ++v) { const float p = __builtin_amdgcn_exp2f(S[kp][v] - mx); S[kp][v] = p; den += p; }
    den += __shfl_xor(den, 16); den += __shfl_xor(den, 32);
    S[9] = (f32x4){0.f, 0.f, 0.f, 0.f};
    f32x4 O[4];
#pragma unroll
    for (int dt = 0; dt < 4; ++dt) O[dt] = (f32x4){0.f, 0.f, 0.f, 0.f};
#pragma unroll
    for (int j = 0; j < 5; ++j) {
        u32x4 pw; pw.x = pk2(S[2 * j][0], S[2 * j][1]); pw.y = pk2(S[2 * j][2], S[2 * j][3]); pw.z = pk2(S[2 * j + 1][0], S[2 * j + 1][1]); pw.w = pk2(S[2 * j + 1][2], S[2 * j + 1][3]);
        const bf16x8 pf = __builtin_bit_cast(bf16x8, pw);
        const int kta = wid + 2 * j; int ktb = kta + 1; ktb = ktb > 15 ? 15 : ktb;
        LAS unsigned char* va = lds + LDS_VT + (16 * kta + 4 * fq + (fr >> 2)) * TS + (fr & 3) * 8;
        LAS unsigned char* vb = lds + LDS_VT + (16 * ktb + 4 * fq + (fr >> 2)) * TS + (fr & 3) * 8;
#pragma unroll
        for (int dt = 0; dt < 4; ++dt) {
            const s16x4 xa = tr_read(va + dt * 32), xb = tr_read(vb + dt * 32);
            const bf16x8 xf = __builtin_shufflevector(xa, xb, 0, 1, 2, 3, 4, 5, 6, 7);
            O[dt] = MFMA16(xf, pf, O[dt]);
        }
    }
    const float rden = __builtin_amdgcn_rcpf(den);
    bf16* op = OP + ((size_t)br * MPAD + rowq) * 512 + h * 64 + 4 * fq;
#pragma unroll
    for (int dt = 0; dt < 4; ++dt) { u32x2 o; o.x = pk2(O[dt][0] * rden, O[dt][1] * rden); o.y = pk2(O[dt][2] * rden, O[dt][3] * rden); *(u32x2*)(op + 16 * dt) = o; }
    if (fq == 0) LP[((size_t)br * MPAD + rowq) * 8 + h] = mx * 0.6931471805599453f + __logf(den);
}

__device__ __forceinline__ void spatial_unit(ArgsK a, LAS unsigned char* lds, int unit, int jl, int tid, int wid, int lane) {
    unsigned char* ws = AWS(a);
    const bf16* VBb = (const bf16*)(ws + WS_VB); const bf16* Zu = (const bf16*)(ws + WS_Z) + 1536; const bf16* WSP = (const bf16*)(ws + WS_WSP); bf16* CAT = (bf16*)(ws + WS_CAT);
    const int fr = lane & 15, fq = lane >> 4;
    const int b = unit >> 7, c = (unit >> 3) & 15, g = unit & 7;
    const size_t r0 = (size_t)b * SEQ + c * 128;
    { u32x4 sv[2];
#pragma unroll
      for (int it = 0; it < 2; ++it) { const int cc = tid + 512 * it, kr = cc >> 3, ch = cc & 7; sv[it] = *(const u32x4*)(VBb + (r0 + kr) * 512 + g * 64 + ch * 8); }
#pragma unroll
      for (int it = 0; it < 2; ++it) { const int cc = tid + 512 * it, kr = cc >> 3, ch = cc & 7; *(LAS u32x4*)(lds + LDS_VT + kr * TS + ch * 16) = sv[it]; } }
    __syncthreads();
    const int i = 16 * wid + fr;
    const bf16* wrow = WSP + ((size_t)(jl * 8 + g) * 128 + i) * 128;
    f32x4 O[4];
#pragma unroll
    for (int dt = 0; dt < 4; ++dt) O[dt] = (f32x4){0.f, 0.f, 0.f, 0.f};
    const int nks = (wid >> 1) + 1;
    for (int js = 0; js < nks; ++js) {
        const u32x2 wa = *(const u32x2*)(wrow + 32 * js + 4 * fq), wb = *(const u32x2*)(wrow + 32 * js + 16 + 4 * fq);
        u32x4 pw; pw.x = wa.x; pw.y = wa.y; pw.z = wb.x; pw.w = wb.y;
        const bf16x8 pf = __builtin_bit_cast(bf16x8, pw);
        LAS unsigned char* va = lds + LDS_VT + (32 * js + 4 * fq + (fr >> 2)) * TS + (fr & 3) * 8;
        LAS unsigned char* vb = va + 16 * TS;
#pragma unroll
        for (int dt = 0; dt < 4; ++dt) {
            const s16x4 xa = tr_read(va + dt * 32), xb = tr_read(vb + dt * 32);
            const bf16x8 xf = __builtin_shufflevector(xa, xb, 0, 1, 2, 3, 4, 5, 6, 7);
            O[dt] = MFMA16(xf, pf, O[dt]);
        }
    }
    const float bs = AIN(a, I_BSP)[(jl * 8 + g) * 128 + i];
    const bf16* up = Zu + (r0 + i) * ZW + g * 64 + 4 * fq; bf16* cp = CAT + (r0 + i) * DM + 512 + g * 64 + 4 * fq;
    u32x2 uq[4];
#pragma unroll
    for (int dt = 0; dt < 4; ++dt) uq[dt] = *(const u32x2*)(up + 16 * dt);
#pragma unroll
    for (int dt = 0; dt < 4; ++dt) {
        const u32x2 uu = uq[dt];
        u32x2 o; o.x = pk2(gelu_tanh(bflo(uu.x)) * (O[dt][0] + bs), gelu_tanh(bfhi(uu.x)) * (O[dt][1] + bs)); o.y = pk2(gelu_tanh(bflo(uu.y)) * (O[dt][2] + bs), gelu_tanh(bfhi(uu.y)) * (O[dt][3] + bs));
        *(u32x2*)(cp + 16 * dt) = o;
    }
}

__device__ __forceinline__ void sample_task(ArgsK a, LAS unsigned char* lds, int task, int jl, int tid, int wid, int lane) {
    unsigned char* ws = AWS(a);
    const bf16* Qb = (const bf16*)(ws + WS_Q); const bf16* Kb = (const bf16*)(ws + WS_K); const bf16* Zv = (const bf16*)(ws + WS_Z) + 1024; bf16* CAT = (bf16*)(ws + WS_CAT);
    const int n = task >> 3, h = task & 7; const size_t row = (size_t)MP + n;
    LAS float* qs = (LAS float*)(lds + 256 * wid);
    LAS float* part = (LAS float*)(lds + 4096);
    LAS float* fin = (LAS float*)(lds + 4096 + 8 * 3 * 68 * 4);
    const float qd = bflo((unsigned)Qb[row * 512 + h * 64 + lane]);
    qs[lane] = qd;
    const float* ck = AIN(a, I_CK) + ((size_t)(jl * MS + n) * 2048) * 512 + h * 64;
    const float* cv = AIN(a, I_CV) + ((size_t)(jl * MS + n) * 2048) * 512 + h * 64;
    const int br = (lane >> 4) > 2 ? 2 : (lane >> 4), el = lane & 15, dsh = 2 * br;
    const bool live = lane < 48;
    const int e = 16 * wid + el;
    const float* kr = ck + (size_t)(2048 - ((e + 1) << dsh)) * 512;
    float s = 0.f;
    { f32x4 kq[16];
#pragma unroll
      for (int c = 0; c < 16; ++c) kq[c] = *(const f32x4*)(kr + 4 * c);
#pragma unroll
      for (int c = 0; c < 16; ++c) { const f32x4 kv = kq[c]; const f32x4 qv = *(const LAS f32x4*)(qs + 4 * c); s += (kv.x * qv.x + kv.y * qv.y) + (kv.z * qv.z + kv.w * qv.w); } }
    s = live ? s * 0.125f : -INFINITY;
    float m = s;
#pragma unroll
    for (int o = 1; o < 16; o <<= 1) m = fmaxf(m, __shfl_xor(m, o));
    const float p = live ? __expf(s - m) : 0.f;
    float l = p;
#pragma unroll
    for (int o = 1; o < 16; o <<= 1) l += __shfl_xor(l, o);
    f32x4 o4 = {0.f, 0.f, 0.f, 0.f};
#pragma unroll
    for (int j = 0; j < 16; ++j) {
        const float pj = __shfl(p, (lane & 48) + j);
        const f32x4 v4 = *(const f32x4*)(cv + (size_t)(2048 - ((16 * wid + j + 1) << dsh)) * 512 + 4 * el);
        o4 += pj * v4;
    }
    if (live) { LAS float* pp = part + (wid * 3 + br) * 68; if (el == 0) { pp[0] = m; pp[1] = l; } *(LAS f32x4*)(pp + 4 + 4 * el) = o4; }
    __syncthreads();
    if (wid < 3) {
        const float kd = bflo((unsigned)Kb[row * 512 + h * 64 + lane]), vd = bflo((unsigned)Zv[row * ZW + h * 64 + lane]);
        const float s_new = wave_sum(qd * kd) * 0.125f;
        float M = s_new;
#pragma unroll
        for (int w = 0; w < 8; ++w) M = fmaxf(M, part[(w * 3 + wid) * 68]);
        float L = __expf(s_new - M), O = L * vd;
#pragma unroll
        for (int w = 0; w < 8; ++w) { const LAS float* pp = part + (w * 3 + wid) * 68; const float f = __expf(pp[0] - M); L += pp[1] * f; O += pp[4 + lane] * f; }
        LAS float* ff = fin + wid * 68; if (lane == 0) ff[0] = M + __logf(L); ff[4 + lane] = O / L;
    }
    __syncthreads();
    if (wid == 0) {
        const float l0 = fin[0], l1 = fin[68], l2 = fin[136]; const float mm = fmaxf(l0, fmaxf(l1, l2));
        const float e0 = __expf(l0 - mm), e1 = __expf(l1 - mm), e2 = __expf(l2 - mm);
        const float att = (e0 * fin[4 + lane] + e1 * fin[68 + 4 + lane] + e2 * fin[136 + 4 + lane]) / (e0 + e1 + e2);
        CAT[row * DM + h * 64 + lane] = (bf16)f2bf(att);
    }
}
__device__ __forceinline__ void sample_gate(ArgsK a, int jl, int gt, int ngt) {
    unsigned char* ws = AWS(a);
    const bf16* VBb = (const bf16*)(ws + WS_VB); const bf16* Zu = (const bf16*)(ws + WS_Z) + 1536; bf16* CAT = (bf16*)(ws + WS_CAT);
    for (int e = gt; e < MS * 512; e += ngt) {
        const int n = e >> 9, c = e & 511, g = c >> 6; const size_t row = (size_t)MP + n;
        const float w00 = AIN(a, I_WSP)[(size_t)(jl * 8 + g) * 128 * 128], b0 = AIN(a, I_BSP)[(jl * 8 + g) * 128];
        const float u = gelu_tanh(bflo((unsigned)Zu[row * ZW + c])), vb = bflo((unsigned)VBb[row * 512 + c]);
        CAT[row * DM + 512 + c] = (bf16)f2bf(u * (w00 * vb + b0));
    }
}

__device__ __forceinline__ float bfly32(const float (&v)[32], int lane) {
    float r16[16], r8[8], r4[4], r2[2];
    { const bool hi = lane & 32;
#pragma unroll
      for (int i = 0; i < 16; ++i) { const float keep = hi ? v[i + 16] : v[i], send = hi ? v[i] : v[i + 16]; r16[i] = keep + __shfl_xor(send, 32); } }
    { const bool hi = lane & 16;
#pragma unroll
      for (int i = 0; i < 8; ++i) { const float keep = hi ? r16[i + 8] : r16[i], send = hi ? r16[i] : r16[i + 8]; r8[i] = keep + __shfl_xor(send, 16); } }
    { const bool hi = lane & 8;
#pragma unroll
      for (int i = 0; i < 4; ++i) { const float keep = hi ? r8[i + 4] : r8[i], send = hi ? r8[i] : r8[i + 4]; r4[i] = keep + __shfl_xor(send, 8); } }
    { const bool hi = lane & 4;
#pragma unroll
      for (int i = 0; i < 2; ++i) { const float keep = hi ? r4[i + 2] : r4[i], send = hi ? r4[i] : r4[i + 2]; r2[i] = keep + __shfl_xor(send, 4); } }
    float r1; { const bool hi = lane & 2; const float keep = hi ? r2[1] : r2[0], send = hi ? r2[0] : r2[1]; r1 = keep + __shfl_xor(send, 2); }
    return r1 + __shfl_xor(r1, 1);
}
__device__ __forceinline__ void conv_phase(ArgsK a, LAS unsigned char* lds, int jl, int tid, int wid, int lane) {
    unsigned char* ws = AWS(a);
    const bf16* X = (const bf16*)(ws + WS_X); bf16* Y = (bf16*)(ws + WS_Y); const float* ZS = (const float*)(ws + WS_ZS);
    const int c0 = 2 * tid;
    float w0[31], w1[31];
#pragma unroll
    for (int w = 0; w < 31; ++w) { const float2 t = *(const float2*)(AIN(a, I_WDW) + (size_t)(jl * 31 + w) * DM + c0); w0[w] = t.x; w1[w] = t.y; }
    const float2 bd = *(const float2*)(AIN(a, I_BDW) + jl * DM + c0), gg = *(const float2*)(AIN(a, I_CG) + jl * DM + c0), be = *(const float2*)(AIN(a, I_CB) + jl * DM + c0);
    LAS float* red = (LAS float*)lds;
    LAS float* tot = (LAS float*)(lds + 2048);
    constexpr int CT = 32, NU = MP / CT;
    for (int unit = bidx(); unit < NU + MS; unit += gridDim.x) {
        if (unit < NU) {
            const int b = unit >> 6, t0 = (unit & 63) * CT; const bool lastu = (unit & 63) == 63;
            unsigned xu[CT + 30];
#pragma unroll
            for (int r = 0; r < CT + 30; ++r) { const int t = t0 - 30 + r, tc = t < 0 ? 0 : t; xu[r] = *(const unsigned*)(X + ((size_t)b * SEQ + tc) * DM + c0); }
            if (lastu) {
#pragma unroll
                for (int r = CT; r < CT + 30; ++r) { float2 o; o.x = bflo(xu[r]); o.y = bfhi(xu[r]); *(float2*)(AOUT(a) + O_CCP + ((size_t)(jl * NB + b) * 30 + (r - CT)) * DM + c0) = o; }
            }
#pragma unroll
            for (int hf = 0; hf < 2; ++hf) {
                float a0[16], a1[16];
#pragma unroll
                for (int tt = 0; tt < 16; ++tt) { a0[tt] = bd.x; a1[tt] = bd.y; }
#pragma unroll
                for (int rr = 0; rr < 46; ++rr) {
                    const int r = 16 * hf + rr, t = t0 - 30 + r;
                    const float x0 = t >= 0 ? bflo(xu[r]) : 0.f, x1 = t >= 0 ? bfhi(xu[r]) : 0.f;
#pragma unroll
                    for (int tt = 0; tt < 16; ++tt) { const int w = rr - tt; if (w >= 0 && w <= 30) { a0[tt] += x0 * w0[w]; a1[tt] += x1 * w1[w]; } }
                }
                {
                    float sv[32];
#pragma unroll
                    for (int tt = 0; tt < 16; ++tt) { sv[tt] = a0[tt] + a1[tt]; sv[16 + tt] = a0[tt] * a0[tt] + a1[tt] * a1[tt]; }
                    const float wt = bfly32(sv, lane);
                    if ((lane & 1) == 0) red[wid * 64 + (lane >> 1)] = wt;
                }
                __syncthreads();
                if (tid < 64) { float s = 0.f;
#pragma unroll
                    for (int w = 0; w < 8; ++w) s += red[w * 64 + tid];
                    tot[tid] = s; }
                __syncthreads();
#pragma unroll
                for (int tt = 0; tt < 16; ++tt) {
                    const float mean = tot[tt] * (1.f / DM), var = fmaxf(tot[tt + 16] * (1.f / DM) - mean * mean, 0.f), rstd = rsqrtf(var + EPS);
                    const float y0 = (a0[tt] - mean) * rstd * gg.x + be.x, y1 = (a1[tt] - mean) * rstd * gg.y + be.y;
                    const float z0 = y0 * __builtin_amdgcn_rcpf(1.f + __expf(-y0)), z1 = y1 * __builtin_amdgcn_rcpf(1.f + __expf(-y1));
                    *(unsigned*)(Y + ((size_t)b * SEQ + t0 + 16 * hf + tt) * DM + c0) = pk2(z0, z1);
                }
                __syncthreads();
            }
        } else {
            const int n = unit - NU;
            const int np = 256 * (c0 >> 7) + (c0 & 127);
            const float2 av = *(const float2*)(ZS + (size_t)n * 2048 + np), gv = *(const float2*)(ZS + (size_t)n * 2048 + np + 128);
            const float xn0 = av.x / (1.f + __expf(-gv.x)), xn1 = av.y / (1.f + __expf(-gv.y));
            float s0 = bd.x + xn0 * w0[30], s1 = bd.y + xn1 * w1[30];
            const float* st = AIN(a, I_CST) + ((size_t)(jl * MS + n) * 30) * DM + c0;
            float* oc = AOUT(a) + O_CCS + ((size_t)(jl * MS + n) * 30) * DM + c0;
            float2 sst[30];
#pragma unroll
            for (int w = 0; w < 30; ++w) sst[w] = *(const float2*)(st + (size_t)w * DM);
#pragma unroll
            for (int w = 0; w < 30; ++w) { const float2 sv = sst[w]; s0 += sv.x * w0[w]; s1 += sv.y * w1[w]; if (w >= 1) *(float2*)(oc + (size_t)(w - 1) * DM) = sv; }
            { float2 o; o.x = xn0; o.y = xn1; *(float2*)(oc + (size_t)29 * DM) = o; }
            const float s = wave_sum(s0 + s1), q = wave_sum(s0 * s0 + s1 * s1);
            if (lane == 0) { red[wid * 64] = s; red[wid * 64 + 16] = q; }
            __syncthreads();
            if (tid < 64) { float t = 0.f;
#pragma unroll
                for (int w = 0; w < 8; ++w) t += red[w * 64 + tid];
                tot[tid] = t; }
            __syncthreads();
            const float mean = tot[0] * (1.f / DM), var = fmaxf(tot[16] * (1.f / DM) - mean * mean, 0.f), rstd = rsqrtf(var + EPS);
            const float y0 = (s0 - mean) * rstd * gg.x + be.x, y1 = (s1 - mean) * rstd * gg.y + be.y;
            *(unsigned*)(Y + ((size_t)MP + n) * DM + c0) = pk2(y0 / (1.f + __expf(-y0)), y1 / (1.f + __expf(-y1)));
            __syncthreads();
        }
    }
}

template <class F> __device__ __forceinline__ void skinny_gemm(LAS unsigned char* lds, const bf16* A, const bf16* Bt, int N, int K, int tid, int wid, int lane, F f) {
    const int fr = lane & 15, fq = lane >> 4; LAS float* red = (LAS float*)lds;
    const int ks = K >> 3;
    for (int cgp = bidx(); cgp < (N >> 4); cgp += gridDim.x) {
        f32x4 acc0 = {0.f, 0.f, 0.f, 0.f}, acc1 = {0.f, 0.f, 0.f, 0.f};
        const bf16* a0p = A + (size_t)fr * K + wid * ks + fq * 8; const bf16* a1p = a0p + (size_t)16 * K; const bf16* bp = Bt + (size_t)(cgp * 16 + fr) * K + wid * ks + fq * 8;
        for (int kk = 0; kk < ks; kk += 128) {
            bf16x8 x[4], y0[4], y1[4];
#pragma unroll
            for (int q = 0; q < 4; ++q) { x[q] = *(const bf16x8*)(bp + kk + 32 * q); y0[q] = *(const bf16x8*)(a0p + kk + 32 * q); y1[q] = *(const bf16x8*)(a1p + kk + 32 * q); }
            __builtin_amdgcn_sched_barrier(0);
#pragma unroll
            for (int q = 0; q < 4; ++q) { acc0 = MFMA16(x[q], y0[q], acc0); acc1 = MFMA16(x[q], y1[q], acc1); }
        }
#pragma unroll
        for (int v = 0; v < 4; ++v) { red[(wid * 32 + fr) * 16 + 4 * fq + v] = acc0[v]; red[(wid * 32 + 16 + fr) * 16 + 4 * fq + v] = acc1[v]; }
        __syncthreads();
        { const int r = tid >> 4, c = tid & 15; float s = 0.f;
#pragma unroll
          for (int w = 0; w < 8; ++w) s += red[(w * 32 + r) * 16 + c];
          f(r, cgp * 16 + c, s); }
        __syncthreads();
    }
}
#ifndef MK_MULTI
#define MK_MULTI 0
#endif
constexpr int N_PHASES = 32;
#ifndef PH_MASK
#define PH_MASK 0xffff
#endif
#define PHON(k) ((PH_MASK >> (k)) & 1)
#ifndef REPEAT_MASK
#define REPEAT_MASK 0
#endif
__device__ __forceinline__ int fresh_tid(int wid0) { int t = wid0 * 64 + (int)__builtin_amdgcn_mbcnt_hi(~0u, __builtin_amdgcn_mbcnt_lo(~0u, 0u)); asm volatile("" : "+v"(t)); return t; }
__global__ void __launch_bounds__(512, 2) fwd_kernel(Args a_unused) {
    extern __shared__ __attribute__((aligned(16))) unsigned char lds_raw[];
    ArgsK ap0 = (ArgsK)__builtin_amdgcn_kernarg_segment_ptr();
    LAS unsigned char* lds = (LAS unsigned char*)lds_raw;
    cg::grid_group grid = cg::this_grid();
    const int wid0 = __builtin_amdgcn_readfirstlane((int)threadIdx.x >> 6);
    const int ph_lo = ap0->ph_lo, ph_hi = ap0->ph_hi;
    volatile LAS unsigned* bst = (volatile LAS unsigned*)(lds + LDS_BAR_OFF);
    if (threadIdx.x < 2) bst[threadIdx.x] = 0u;
    __syncthreads();
    XcdBarrier xbar; xbar.bar = (unsigned*)(AWS(ap0) + WS_BAR); xbar.x = 0; xbar.st = bst;
    if (ph_hi - ph_lo > 1) xbar = xcd_barrier_post((unsigned*)(AWS(ap0) + WS_BAR), bst);
    if (ph_lo < 0) grid.sync();
    for (int ph = ph_lo; ph < ph_hi; ++ph) {
        const int kind0 = ph - (ph >= 16 ? 16 : 0);
        if (ph != 0 && (kind0 == 0 || kind0 == 6 || kind0 == 9 || kind0 == 13)) continue;
        const int reps = ((REPEAT_MASK >> kind0) & 1) ? 2 : 1;
        for (int rep = 0; rep < reps; ++rep) {
        int phv = ph; asm volatile("" : "+s"(phv));
        const int half = phv >= 16 ? 1 : 0, kind = phv - 16 * half, L = 2 * half + (kind >= 9 ? 1 : 0), jl = half;
        const bool is_gemm = (kind == 1 || kind == 5 || kind == 7 || kind == 8 || kind == 10 || kind == 12 || kind == 14 || kind == 15);
        if (is_gemm) {
            {
                ArgsK ap = ap0; asm volatile("" : "+s"(ap));
                GemmCfg c; gemm_cfg(ap, phv, c);
                EpiAll E{ap0, phv};
                pg8::Gemm g{c.A, c.B, MP, c.N, c.K}; pg8::StaticOrder S; S.init(MP, c.N, (int)gridDim.x, bidx());
                pg8::gemm_phase<EpiAll, pg8::StaticOrder, true, true>(lds, g, S, E, fresh_tid(wid0));
            }
            {
                ArgsK ap = ap0; asm volatile("" : "+s"(ap));
                GemmCfg c; gemm_cfg(ap, phv, c);
                const int gmode = c.mode; bf16* gO = c.O; const int gld = c.ld; const rs_t* rs = c.rs; rs_t* rsn = c.rsn;
                const float* xs = c.xins; float* ys = c.yout + O_YS; bf16* hbs = c.hb + (size_t)MP * DM; const bool first = c.first, last = c.last;
                float* zs = (float*)(AWS(ap) + WS_ZS);
                const int tid = fresh_tid(wid0), wid = __builtin_amdgcn_readfirstlane(tid >> 6), lane = tid & 63;
                skinny_gemm(lds, c.A + (size_t)MP * c.K, c.B, c.N, c.K, tid, wid, lane, [=](int r, int cc, float v) {
                    if (gmode == 3) {
                        const float hv = (first ? xs[r * DM + cc] : bflo((unsigned)hbs[r * DM + cc])) + v;
                        if (last) ys[r * DM + cc] = hv; else hbs[r * DM + cc] = (bf16)f2bf(hv);
                        if (rsn) { float ss = hv * hv; ss += __shfl_xor(ss, 1); ss += __shfl_xor(ss, 2); ss += __shfl_xor(ss, 4); ss += __shfl_xor(ss, 8);
                            if ((cc & 15) == 0) atomicAdd(rsn + MP + r, rs_enc(ss)); }
                    } else {
                        const float sv = v * rs_scale(rs[MP + r]);
                        if (gmode == 2) zs[r * 2048 + cc] = sv;
                        else { const float t = fmaxf(sv, 0.f); gO[(size_t)(MP + r) * gld + cc] = (bf16)f2bf(gmode == 1 ? t * t : sv); }
                    }
                });
            }
            if (phv == 1 || phv == 17) {
                ArgsK ap = ap0; asm volatile("" : "+s"(ap));
                const int G = (int)gridDim.x, nrem = 640 % G, c = bidx();
                const bool all = (nrem == 0); const int nhelp = all ? G : G - nrem, hidx = all ? c : c - nrem;
                if (hidx >= 0) { const int tid = fresh_tid(wid0), wid = __builtin_amdgcn_readfirstlane(tid >> 6), lane = tid & 63; convert_set(ap, phv == 1 ? 1 : 2, hidx * 8 + wid, nhelp * 8, lane); }
            }
        } else {
            ArgsK a = ap0; asm volatile("" : "+s"(a));
            const int tid = fresh_tid(wid0), wid = __builtin_amdgcn_readfirstlane(tid >> 6), lane = tid & 63;
            switch (kind) {
            case 0: case 6: case 9: case 13: if (PHON(0)) {
                if (phv == 0 && rep == 0) { const int npro = ((REPEAT_MASK >> 16) & 1) ? 2 : 1; for (int q = 0; q < npro; ++q) { prologue(a, lds, tid, wid, lane); __syncthreads(); } }
            } break;
            case 2: if (PHON(2)) post_phase(a, jl, wid, lane); break;
            case 3: if (PHON(3)) {
                for (int rq = 0; rq < (((REPEAT_MASK >> 17) & 1) ? 2 : 1); ++rq) {
                    const int G = (int)gridDim.x, c = bidx(); const bool xmap = (G == 256);
                    const int nr = xmap ? 12 : (3072 - c + G - 1) / G;
                    u32x4 kvA[4], vvA[4], kvB[4], vvB[4]; bf16x8 qA0 = {0, 0, 0, 0, 0, 0, 0, 0}, qA1 = qA0, qB0 = qA0, qB1 = qA0;
#pragma unroll
                    for (int i = 0; i < 4; ++i) { kvA[i] = (u32x4){0u, 0u, 0u, 0u}; vvA[i] = kvA[i]; kvB[i] = kvA[i]; vvB[i] = kvA[i]; }
#define ATT_UNIT(r_) (xmap ? ((((r_) * 32 + (c >> 3)) >> 7) * 1024 + (((((((r_) * 32 + (c >> 3)) >> 4) & 7) << 3) + (c & 7)) << 4) + (((r_) * 32 + (c >> 3)) & 15)) : (c + (r_) * G))
                    constexpr int ABUF = 2 * 256 * TS;
                    if (nr > 0) { const int u0 = ATT_UNIT(0); attn_load(a, u0, tid, kvA, vvA); attn_loadq(a, u0, wid, lane, qA0, qA1); }
                    if (nr > 1) { const int u1 = ATT_UNIT(1); attn_load(a, u1, tid, kvB, vvB); attn_loadq(a, u1, wid, lane, qB0, qB1); }
                    __syncthreads();
                    if (nr > 0) attn_stage(lds, tid, kvA, vvA);
                    __syncthreads();
#pragma unroll 1
                    for (int r = 0; r < nr; r += 2) {
                        {
                            const int u = ATT_UNIT(r); const bf16x8 qf0 = qA0, qf1 = qA1;
                            if (r + 1 < nr) attn_stage(lds + ABUF, tid, kvB, vvB);
                            if (r + 2 < nr) { const int un = ATT_UNIT(r + 2); attn_load(a, un, tid, kvA, vvA); attn_loadq(a, un, wid, lane, qA0, qA1); }
                            attn_compute(a, lds, u, wid, lane, qf0, qf1);
                            __syncthreads();
                        }
                        if (r + 1 < nr) {
                            const int u = ATT_UNIT(r + 1); const bf16x8 qf0 = qB0, qf1 = qB1;
                            if (r + 2 < nr) attn_stage(lds, tid, kvA, vvA);
                            if (r + 3 < nr) { const int un = ATT_UNIT(r + 3); attn_load(a, un, tid, kvB, vvB); attn_loadq(a, un, wid, lane, qB0, qB1); }
                            attn_compute(a, lds + ABUF, u, wid, lane, qf0, qf1);
                            __syncthreads();
                        }
                    }
#undef ATT_UNIT
                }
                for (int rq = 0; rq < (((REPEAT_MASK >> 18) & 1) ? 2 : 1); ++rq)
                for (int u = bidx(); u < 1024; u += gridDim.x) { __syncthreads(); spatial_unit(a, lds, u, jl, tid, wid, lane); }
                for (int rq = 0; rq < (((REPEAT_MASK >> 19) & 1) ? 2 : 1); ++rq)
                for (int u = bidx(); u < MS * 8; u += gridDim.x) { __syncthreads(); sample_task(a, lds, u, jl, tid, wid, lane); }
                sample_gate(a, jl, bidx() * 512 + tid, gridDim.x * 512);
            } break;
            case 4: if (PHON(4)) combine_phase(a, wid, lane); break;
            case 11: if (PHON(11)) conv_phase(a, lds, jl, tid, wid, lane); break;
            default: break;
            }
        }
        if (rep + 1 < reps) __syncthreads();
        }
#ifndef SYNC_REPS
#define SYNC_REPS 1
#endif
        if (ph + 1 < ph_hi) { for (int q = 0; q < SYNC_REPS; ++q) { XcdBarrier b2 = xbar; asm volatile("" : "+s"(b2.bar)); xcd_barrier(b2); } }
    }
}

extern "C" void kernel_launch(void* const* d_in, const int* in_sizes, int n_in, void* d_out, int out_size, void* d_ws, size_t ws_size, hipStream_t stream) {
    static int grid = 0;
    if (grid == 0) {
        if (n_in != 23 || (size_t)out_size != O_END || ws_size < WS_END) { fprintf(stderr, "kernel_launch: unexpected sizes n_in %d out %d ws %zu\n", n_in, out_size, ws_size); grid = -1; return; }
        int dev = 0, cus = 0, per_cu = 0;
        (void)hipGetDevice(&dev); (void)hipDeviceGetAttribute(&cus, hipDeviceAttributeMultiprocessorCount, dev);
        if (hipFuncSetAttribute((const void*)fwd_kernel, hipFuncAttributeMaxDynamicSharedMemorySize, LDS_BYTES) != hipSuccess) { fprintf(stderr, "kernel_launch: hipFuncSetAttribute failed\n"); grid = -1; return; }
        if (hipOccupancyMaxActiveBlocksPerMultiprocessor(&per_cu, (const void*)fwd_kernel, 512, LDS_BYTES) != hipSuccess || per_cu < 1) { fprintf(stderr, "kernel_launch: occupancy query failed (%d)\n", per_cu); (void)hipGetLastError(); per_cu = 1; }
        grid = cus * per_cu;
        if (grid <= 0) grid = 256;
    }
    if (grid < 0) return;
    if (hipMemsetAsync((char*)d_ws + WS_BAR, 0, 16384, stream) != hipSuccess) { fprintf(stderr, "kernel_launch: memset of barrier words failed\n"); return; }
    Args a{};
    for (int i = 0; i < 23; ++i) a.in[i] = (GAS const float*)d_in[i];
    a.out = (GAS float*)d_out; a.ws = (GAS unsigned char*)d_ws;
#if MK_MULTI
    for (int ph = 0; ph < N_PHASES; ++ph) { a.ph_lo = ph; a.ph_hi = ph + 1; hipLaunchKernelGGL(fwd_kernel, dim3(grid), dim3(512), LDS_BYTES, stream, a); }
#else
    a.ph_lo = 0; a.ph_hi = N_PHASES;
    void* args[] = {&a};
    hipError_t e = hipLaunchCooperativeKernel((const void*)fwd_kernel, dim3(grid), dim3(512), args, LDS_BYTES, stream);
    if (e != hipSuccess) fprintf(stderr, "cooperative launch failed: %s (grid %d)\n", hipGetErrorString(e), grid);
#endif
}
```
